# Optimizing an MI355X kernel written in HIP

```python
import jax, jax.numpy as jnp
from jax import lax
import numpy as np

D_MODEL = 1024
BATCH = 8
SEQ = 2048
DEPTH = 1
DEC_BATCH = 4
DEC_SEQ = 8192
PAST_LEN = 128

N_ATTN_HEADS = 8
N_KV_HEADS = 2
ATTN_HEAD_DIM = 64
WINDOW = 128
ATTN_BLOCK = 128
ROPE_THETA = 10000.0
N_GLA_HEADS = 4
GLA_KEY_DIM = 64
GLA_VALUE_DIM = 128
GLA_GATE_RANK = 16
GLA_GATE_NORMALIZER = 16.0
GLA_CHUNK = 64
D_FF = 2816
EPS = 1e-6

ATTN_Q = N_ATTN_HEADS * ATTN_HEAD_DIM
ATTN_KV = N_KV_HEADS * ATTN_HEAD_DIM
GLA_QK = N_GLA_HEADS * GLA_KEY_DIM
GLA_V = N_GLA_HEADS * GLA_VALUE_DIM
MIX_WIDTH = ATTN_Q + GLA_V
IN_SPLIT_OFFSETS = [ATTN_Q, ATTN_Q + ATTN_KV, ATTN_Q + 2 * ATTN_KV, ATTN_Q + 2 * ATTN_KV + GLA_QK, ATTN_Q + 2 * ATTN_KV + 2 * GLA_QK, ATTN_Q + 2 * ATTN_KV + 2 * GLA_QK + GLA_V, ATTN_Q + 2 * ATTN_KV + 2 * GLA_QK + 2 * GLA_V, ATTN_Q + 2 * ATTN_KV + 2 * GLA_QK + 2 * GLA_V + GLA_GATE_RANK]
IN_PROJ_WIDTH = ATTN_Q + 2 * ATTN_KV + 2 * GLA_QK + 2 * GLA_V + 2 * GLA_GATE_RANK

kernel_name = 'hymba_swa_gla_macaron_encoder'


def rmsnorm(x, gain):
    xf = x.astype(jnp.float32)
    y = xf * lax.rsqrt(jnp.mean(xf * xf, axis=-1, keepdims=True) + EPS)
    return (y * gain.astype(jnp.float32)).astype(x.dtype)


def swiglu(h, w_gate, w_up, w_down):
    return (jax.nn.silu(h @ w_gate) * (h @ w_up)) @ w_down


def rotary(x):
    T, d = x.shape[1], x.shape[-1]
    half = d // 2
    inv_freq = ROPE_THETA ** (-jnp.arange(half, dtype=jnp.float32) / half)
    ang = jnp.arange(T, dtype=jnp.float32)[:, None] * inv_freq[None, :]
    cos = jnp.cos(ang)[None, :, None, :]
    sin = jnp.sin(ang)[None, :, None, :]
    xf = x.astype(jnp.float32)
    x1, x2 = xf[..., :half], xf[..., half:]
    return jnp.concatenate([x1 * cos - x2 * sin, x2 * cos + x1 * sin], axis=-1).astype(x.dtype)


def windowed_gqa_attention(q, k, v, sink):
    B, T, Hq, d = q.shape
    nb = T // ATTN_BLOCK
    G = Hq // N_KV_HEADS
    pad = ((0, 0), (ATTN_BLOCK, ATTN_BLOCK), (0, 0), (0, 0))
    kp = jnp.pad(k, pad).reshape(B, nb + 2, ATTN_BLOCK, N_KV_HEADS, d)
    vp = jnp.pad(v, pad).reshape(B, nb + 2, ATTN_BLOCK, N_KV_HEADS, d)
    kw = jnp.concatenate([kp[:, :-2], kp[:, 1:-1], kp[:, 2:]], axis=2)
    vw = jnp.concatenate([vp[:, :-2], vp[:, 1:-1], vp[:, 2:]], axis=2)
    qb = q.reshape(B, nb, ATTN_BLOCK, N_KV_HEADS, G, d)
    s = jnp.einsum('bnqhgd,bnkhd->bnhgqk', qb, kw).astype(jnp.float32) * (d ** -0.5)
    i = jnp.arange(ATTN_BLOCK)[:, None]
    j = jnp.arange(3 * ATTN_BLOCK)[None, :]
    rel = j - ATTN_BLOCK - i
    kpos = (jnp.arange(nb)[:, None, None] - 1) * ATTN_BLOCK + j[None]
    mask = (jnp.abs(rel)[None] <= WINDOW) & (kpos >= 0) & (kpos < T)
    mask = mask[None, :, None, None, :, :]
    s = jnp.where(mask, s, -1e30)
    sink_b = sink.astype(jnp.float32).reshape(N_KV_HEADS, G)[None, None, :, :, None, None]
    m = jnp.maximum(jnp.max(s, axis=-1, keepdims=True), sink_b)
    p = jnp.where(mask, jnp.exp(s - m), 0.0)
    denom = jnp.sum(p, axis=-1, keepdims=True) + jnp.exp(sink_b - m)
    probs = (p / denom).astype(v.dtype)
    o = jnp.einsum('bnhgqk,bnkhd->bnqhgd', probs, vw)
    return o.reshape(B, T, Hq * d)


def gla_chunked(q, k, v, log_a, strict):
    B, H, T, dk = q.shape
    dv = v.shape[-1]
    C = GLA_CHUNK
    n = T // C
    q = q.reshape(B, H, n, C, dk)
    k = k.reshape(B, H, n, C, dk)
    v = v.reshape(B, H, n, C, dv)
    b = jnp.cumsum(log_a.reshape(B, H, n, C, dk), axis=3)
    b_last = b[:, :, :, -1:, :]
    q_e = q * jnp.exp(b)
    k_e = k * jnp.exp(-b)
    tri = jnp.tril(jnp.ones((C, C), jnp.float32), k=-1 if strict else 0)
    A = jnp.einsum('bhnid,bhnjd->bhnij', q_e, k_e) * tri
    o_intra = jnp.einsum('bhnij,bhnjv->bhniv', A, v)
    k_s = k * jnp.exp(b_last - b)
    U = jnp.einsum('bhnjd,bhnjv->bhndv', k_s, v)
    decay = jnp.exp(b_last[:, :, :, 0, :])

    def step(S, inp):
        dec, u = inp
        return dec[..., None] * S + u, S

    S0 = jnp.zeros((B, H, dk, dv), jnp.float32)
    _, S_prev = lax.scan(step, S0, (jnp.moveaxis(decay, 2, 0), jnp.moveaxis(U, 2, 0)))
    S_prev = jnp.moveaxis(S_prev, 0, 2)
    o_inter = jnp.einsum('bhnid,bhndv->bhniv', q_e, S_prev)
    return (o_intra + o_inter).reshape(B, H, T, dv)


def hybrid_mixer(h, w_in, attn_sink, w_gla_decay_fwd, b_gla_decay_fwd, w_gla_decay_bwd, b_gla_decay_bwd, gla_out_norm, w_out):
    B, T, _ = h.shape
    proj = h @ w_in
    aq, ak, av, gq, gk, gv, gg, r_f, r_b = jnp.split(proj, IN_SPLIT_OFFSETS, axis=-1)
    aq = rotary(aq.reshape(B, T, N_ATTN_HEADS, ATTN_HEAD_DIM))
    ak = rotary(ak.reshape(B, T, N_KV_HEADS, ATTN_HEAD_DIM))
    av = av.reshape(B, T, N_KV_HEADS, ATTN_HEAD_DIM)
    o_attn = windowed_gqa_attention(aq, ak, av, attn_sink)

    def to_heads(t, dh):
        return t.reshape(B, T, -1, dh).transpose(0, 2, 1, 3).astype(jnp.float32)

    q_g = to_heads(gq, GLA_KEY_DIM) * (GLA_KEY_DIM ** -0.5)
    k_g = to_heads(gk, GLA_KEY_DIM)
    v_g = to_heads(gv, GLA_VALUE_DIM)
    la_f = to_heads(jax.nn.log_sigmoid((r_f @ w_gla_decay_fwd + b_gla_decay_fwd).astype(jnp.float32)) / GLA_GATE_NORMALIZER, GLA_KEY_DIM)
    la_b = to_heads(jax.nn.log_sigmoid((r_b @ w_gla_decay_bwd + b_gla_decay_bwd).astype(jnp.float32)) / GLA_GATE_NORMALIZER, GLA_KEY_DIM)
    o_f = gla_chunked(q_g, k_g, v_g, la_f, False)
    o_b = jnp.flip(gla_chunked(jnp.flip(q_g, 2), jnp.flip(k_g, 2), jnp.flip(v_g, 2), jnp.flip(la_b, 2), True), 2)
    o_g = (o_f + o_b).transpose(0, 2, 1, 3)
    o_g = rmsnorm(o_g, gla_out_norm) * jax.nn.silu(gg.astype(jnp.float32).reshape(B, T, N_GLA_HEADS, GLA_VALUE_DIM))
    o_gla = o_g.reshape(B, T, GLA_V).astype(h.dtype)

    return jnp.concatenate([o_attn, o_gla], axis=-1) @ w_out


def encoder_trunk(x, norm_ffn1, w_ffn1_gate, w_ffn1_up, w_ffn1_down, norm_mix, w_in, attn_sink, w_gla_decay_fwd, b_gla_decay_fwd, w_gla_decay_bwd, b_gla_decay_bwd, gla_out_norm, w_out, norm_ffn2, w_ffn2_gate, w_ffn2_up, w_ffn2_down, norm_final):
    for l in range(DEPTH):
        x = x + 0.5 * swiglu(rmsnorm(x, norm_ffn1[l]), w_ffn1_gate[l], w_ffn1_up[l], w_ffn1_down[l])
        x = x + hybrid_mixer(rmsnorm(x, norm_mix[l]), w_in[l], attn_sink[l], w_gla_decay_fwd[l], b_gla_decay_fwd[l], w_gla_decay_bwd[l], b_gla_decay_bwd[l], gla_out_norm[l], w_out[l])
        x = x + 0.5 * swiglu(rmsnorm(x, norm_ffn2[l]), w_ffn2_gate[l], w_ffn2_up[l], w_ffn2_down[l])
    return rmsnorm(x, norm_final)


def setup_inputs(seed: int = 0) -> dict:
    key = jax.random.key(seed)
    ks = jax.random.split(key, 24)
    f32 = jnp.float32

    def w(k, shape, fan_in):
        return jax.random.normal(k, shape, f32) * (fan_in ** -0.5)

    def gain(k, shape):
        return 1.0 + 0.01 * jax.random.normal(k, shape, f32)

    return {
        'x_prompt': jax.random.normal(ks[0], (BATCH, SEQ, D_MODEL), f32),
        'x_sample': jax.random.normal(ks[1], (DEC_BATCH, DEC_SEQ, D_MODEL), f32),
        'norm_ffn1': gain(ks[2], (DEPTH, D_MODEL)),
        'w_ffn1_gate': w(ks[3], (DEPTH, D_MODEL, D_FF), D_MODEL),
        'w_ffn1_up': w(ks[4], (DEPTH, D_MODEL, D_FF), D_MODEL),
        'w_ffn1_down': w(ks[5], (DEPTH, D_FF, D_MODEL), D_FF),
        'norm_mix': gain(ks[6], (DEPTH, D_MODEL)),
        'w_in': w(ks[7], (DEPTH, D_MODEL, IN_PROJ_WIDTH), D_MODEL),
        'attn_sink': 0.5 * jax.random.normal(ks[8], (DEPTH, N_ATTN_HEADS), f32),
        'w_gla_decay_fwd': w(ks[9], (DEPTH, GLA_GATE_RANK, GLA_QK), GLA_GATE_RANK),
        'b_gla_decay_fwd': 0.1 * jax.random.normal(ks[10], (DEPTH, GLA_QK), f32),
        'w_gla_decay_bwd': w(ks[11], (DEPTH, GLA_GATE_RANK, GLA_QK), GLA_GATE_RANK),
        'b_gla_decay_bwd': 0.1 * jax.random.normal(ks[12], (DEPTH, GLA_QK), f32),
        'gla_out_norm': gain(ks[13], (DEPTH, GLA_VALUE_DIM)),
        'w_out': w(ks[14], (DEPTH, MIX_WIDTH, D_MODEL), MIX_WIDTH),
        'norm_ffn2': gain(ks[15], (DEPTH, D_MODEL)),
        'w_ffn2_gate': w(ks[16], (DEPTH, D_MODEL, D_FF), D_MODEL),
        'w_ffn2_up': w(ks[17], (DEPTH, D_MODEL, D_FF), D_MODEL),
        'w_ffn2_down': w(ks[18], (DEPTH, D_FF, D_MODEL), D_FF),
        'norm_final': gain(ks[19], (D_MODEL,)),
    }


def reference(x_prompt, x_sample, norm_ffn1, w_ffn1_gate, w_ffn1_up, w_ffn1_down, norm_mix, w_in, attn_sink, w_gla_decay_fwd, b_gla_decay_fwd, w_gla_decay_bwd, b_gla_decay_bwd, gla_out_norm, w_out, norm_ffn2, w_ffn2_gate, w_ffn2_up, w_ffn2_down, norm_final):
    y_prompt = encoder_trunk(x_prompt, norm_ffn1, w_ffn1_gate, w_ffn1_up, w_ffn1_down, norm_mix, w_in, attn_sink, w_gla_decay_fwd, b_gla_decay_fwd, w_gla_decay_bwd, b_gla_decay_bwd, gla_out_norm, w_out, norm_ffn2, w_ffn2_gate, w_ffn2_up, w_ffn2_down, norm_final)
    y_sample = encoder_trunk(x_sample, norm_ffn1, w_ffn1_gate, w_ffn1_up, w_ffn1_down, norm_mix, w_in, attn_sink, w_gla_decay_fwd, b_gla_decay_fwd, w_gla_decay_bwd, b_gla_decay_bwd, gla_out_norm, w_out, norm_ffn2, w_ffn2_gate, w_ffn2_up, w_ffn2_down, norm_final)
    return (y_prompt, y_sample)
```

```cpp
#include <hip/hip_runtime.h>
#include <hip/hip_cooperative_groups.h>
#include <cstdio>
namespace cg = cooperative_groups;

#define LAS __attribute__((address_space(3)))
typedef unsigned short bf16_t;
typedef short bf16x8 __attribute__((ext_vector_type(8)));
typedef short s16x4 __attribute__((ext_vector_type(4)));
typedef float f32x4 __attribute__((ext_vector_type(4)));
typedef float f32x2 __attribute__((ext_vector_type(2)));
typedef float f32x16 __attribute__((ext_vector_type(16)));
typedef unsigned u32x4 __attribute__((ext_vector_type(4)));
typedef unsigned u32x2 __attribute__((ext_vector_type(2)));
typedef __bf16 bf2_t __attribute__((ext_vector_type(2)));
#define DI __device__ __forceinline__

constexpr int M_TOK = 49152, MP = 16384, DM = 1024, FF = 2816, NGU = 5632, NIN = 2304, NINL = 2336;
constexpr float EPS = 1e-6f, LOG2E = 1.4426950408889634f;
constexpr size_t MiB = 1048576;
constexpr size_t OFF_WGU1 = 0, OFF_WD1 = 11534336, OFF_WIN = 17301504, OFF_WOUT = 22544384, OFF_WGU2 = 24641536, OFF_WD2 = 36175872;
constexpr size_t OFF_ROPE = 40 * MiB, OFF_SS = 42 * MiB, SS_BYTES = 3 * MiB, OFF_DECAY = 54 * MiB, OFF_XB = 56 * MiB, OFF_BIG = 152 * MiB;
constexpr size_t OFF_Q = OFF_BIG, OFF_K = OFF_BIG + 48 * MiB, OFF_V = OFF_BIG + 60 * MiB, OFF_GQ = OFF_BIG + 72 * MiB, OFF_GK = OFF_BIG + 96 * MiB,
                 OFF_GV = OFF_BIG + 120 * MiB, OFF_SG = OFF_BIG + 168 * MiB, OFF_RR = OFF_BIG + 216 * MiB, OFF_MIX = OFF_BIG + 222 * MiB;
constexpr size_t OFF_SMALL = OFF_DECAY + 1600 * 1024;
constexpr int SM_SINK = 0, SM_WDF = 64, SM_BDF = 4160, SM_WDB = 4416, SM_BDB = 8512, SM_GN = 8768, SM_NF = 8896, SM_TOTAL = 9920;
constexpr int RSTD_OFF = 131072, RSTD_MAXU = 18;
constexpr size_t OFF_WRF = OFF_WIN + (size_t)2304 * 2048;
constexpr int XB_LDS_OFF = RSTD_OFF + RSTD_MAXU * 1024;
constexpr int LDS_BYTES = XB_LDS_OFF + 16;

struct Params { const float* in[20]; float* out; unsigned char* ws; };

DI unsigned pk2(float a, float b) { f32x2 v = {a, b}; bf2_t r = __builtin_convertvector(v, bf2_t); return __builtin_bit_cast(unsigned, r); }
DI float bf2f(unsigned short b) { return __uint_as_float(((unsigned)b) << 16); }
DI float bflo(unsigned u) { return __uint_as_float(u << 16); }
DI float bfhi(unsigned u) { return __uint_as_float(u & 0xffff0000u); }
DI void lds_wait() { asm volatile("s_waitcnt lgkmcnt(0)" ::: "memory"); __builtin_amdgcn_wave_barrier(); }
#define MFMA32(a, b, c) __builtin_amdgcn_mfma_f32_32x32x16_bf16((a), (b), (c), 0, 0, 0)
DI float xh_max(float v) { const auto r = __builtin_amdgcn_permlane32_swap(__float_as_uint(v), __float_as_uint(v), false, false); return fmaxf(__uint_as_float(r[0]), __uint_as_float(r[1])); }
DI float xh_sum(float v) { const auto r = __builtin_amdgcn_permlane32_swap(__float_as_uint(v), __float_as_uint(v), false, false); return __uint_as_float(r[0]) + __uint_as_float(r[1]); }
DI u32x4 widen_pair(u32x2 a, u32x2 b) {
    const auto r0 = __builtin_amdgcn_permlane32_swap(a.x, b.x, false, false); const auto r1 = __builtin_amdgcn_permlane32_swap(a.y, b.y, false, false);
    return (u32x4){r0[0], r1[0], r0[1], r1[1]}; }
DI int crow(int reg, int h) { return (reg & 3) + 8 * (reg >> 2) + 4 * h; }
DI s16x4 trr(LAS unsigned char* p) { return __builtin_amdgcn_ds_read_tr16_b64_v4i16((LAS s16x4*)p); }
DI bf16x8 cat8(s16x4 lo, s16x4 hi) { return __builtin_shufflevector(lo, hi, 0, 1, 2, 3, 4, 5, 6, 7); }
DI bf16x8 pack8(float a0, float a1, float a2, float a3, float a4, float a5, float a6, float a7) {
    u32x4 p = {pk2(a0, a1), pk2(a2, a3), pk2(a4, a5), pk2(a6, a7)}; return __builtin_bit_cast(bf16x8, p); }
DI float silu_f(float g) { return g * __builtin_amdgcn_rcpf(1.0f + __expf(-g)); }
DI float row_ss(const float* ssb, int row) { const f32x4* q = (const f32x4*)(ssb + (size_t)row * 16); f32x4 a = q[0], b = q[1], c = q[2], d = q[3];
    return ((a.x + a.y) + (a.z + a.w)) + ((b.x + b.y) + (b.z + b.w)) + ((c.x + c.y) + (c.z + c.w)) + ((d.x + d.y) + (d.z + d.w)); }

DI int opq_i(int v) { asm volatile("" : "+v"(v)); return __builtin_amdgcn_readfirstlane(v); }
template <class T> DI T* opq_p(T* ptr) { unsigned lo = (unsigned)(unsigned long long)ptr, hi = (unsigned)((unsigned long long)ptr >> 32); asm volatile("" : "+v"(lo), "+v"(hi));
    lo = __builtin_amdgcn_readfirstlane(lo); hi = __builtin_amdgcn_readfirstlane(hi);
    typedef __attribute__((address_space(1))) T* gptr_t; return (T*)(gptr_t)(((unsigned long long)hi << 32) | lo); }
constexpr size_t OFF_BAR = OFF_DECAY + 1700 * 1024;
#define XB_TMO      128
#define XB_XCNT(j)  (256  + 64 * (j))
#define XB_XSUB(j)  (1280 + 64 * (j))
#define XB_XGEN(j)  (2304 + 64 * (j))
#define XB_TOP      3328
#define XB_TOPGEN   3392
#define XCD_BAR_WORDS 3456
#define XB_SPIN_CAP (1u << 20)
DI unsigned xb_ld(unsigned* p)              { return __hip_atomic_load(p, __ATOMIC_RELAXED, __HIP_MEMORY_SCOPE_AGENT); }
DI unsigned xb_add(unsigned* p, unsigned v) { return __hip_atomic_fetch_add(p, v, __ATOMIC_RELAXED, __HIP_MEMORY_SCOPE_AGENT); }
DI unsigned xb_xcc_id() { return (unsigned)__builtin_amdgcn_s_getreg((3 << 11) | 20) & 0xFu; }
#define XB_SPIN(cond, bar) do { unsigned _sp = 0; while (cond) { __builtin_amdgcn_s_sleep(1); \
    if ((++_sp & 255u) == 0u) { if (xb_ld(&(bar)[XB_TMO])) break; if (_sp > XB_SPIN_CAP) { atomicAdd(&(bar)[XB_TMO], 1u); break; } } } } while (0)
DI void xcd_barrier_complete(unsigned* bar, unsigned x, unsigned& nloc, unsigned& nx) {
    const unsigned G = gridDim.x * gridDim.y * gridDim.z;
    unsigned sum, cnt, mine, sp = 0u;
    for (;;) {
        sum = 0u; cnt = 0u; mine = 0u;
#pragma unroll
        for (unsigned j = 0; j < 16; ++j) { const unsigned c = xb_ld(&bar[XB_XCNT(j)]); sum += c; cnt += (c > 0u) ? 1u : 0u; mine = (j == x) ? c : mine; }
        if (sum == G) break;
        __builtin_amdgcn_s_sleep(1);
        if ((++sp & 255u) == 0u) { if (xb_ld(&bar[XB_TMO])) break; if (sp > XB_SPIN_CAP) { atomicAdd(&bar[XB_TMO], 1u); break; } }
    }
    nloc = mine > 0u ? mine : 1u; nx = cnt > 0u ? cnt : 1u;
}
DI void xcd_barrier(unsigned* bar, volatile LAS unsigned* st) {
    asm volatile("s_waitcnt vmcnt(0)" ::: "memory");
    __syncthreads();
    if (threadIdx.x == 0) {
        const unsigned x = xb_xcc_id();
        __builtin_amdgcn_s_waitcnt(0);
        unsigned nloc = st[0], nx = st[1];
        if (nloc == 0u) { xcd_barrier_complete(bar, x, nloc, nx); st[0] = nloc; st[1] = nx; }
        const unsigned old = xb_add(&bar[XB_XSUB(x)], 1u);
        const unsigned gen = old / nloc;
        if (old + 1u == (gen + 1u) * nloc) {
            __builtin_amdgcn_fence(__ATOMIC_RELEASE, "agent");
            asm volatile("s_waitcnt vmcnt(0)" ::: "memory");
            const unsigned og = xb_add(&bar[XB_TOP], 1u);
            const unsigned tg = og / nx;
            if (og + 1u == (tg + 1u) * nx) xb_add(&bar[XB_TOPGEN], 1u);
            else XB_SPIN(xb_ld(&bar[XB_TOPGEN]) == tg, bar);
            __builtin_amdgcn_fence(__ATOMIC_ACQUIRE, "agent");
            xb_add(&bar[XB_XGEN(x)], 1u);
            asm volatile("s_waitcnt vmcnt(0)" ::: "memory");
        } else {
            XB_SPIN(xb_ld(&bar[XB_XGEN(x)]) == gen, bar);
            __builtin_amdgcn_fence(__ATOMIC_ACQUIRE, "agent");
            asm volatile("s_waitcnt vmcnt(0)" ::: "memory");
        }
    }
    __syncthreads();
}

namespace pg8 {
#define PG8_LAS __attribute__((address_space(3)))
constexpr int BM = 256, BK = 64, HALF = 128, HTB = HALF * BK * 2, STAGE_BYTES = 8 * HTB, NXCD = 8, WGM = 8;
__host__ __device__ __forceinline__ int lds_byte(int r, int c) { const int st = (r >> 4) * 2 + (c >> 5), rr = r & 15, cc = c & 31, ob = rr * 64 + cc * 2; return st * 1024 + (ob ^ (((ob >> 9) & 1) << 5)); }
__host__ __device__ __forceinline__ void stage_rc(int b, int& R, int& C) { const int st = b / 1024, sb = b % 1024, swz = sb ^ (((sb >> 9) & 1) << 5); R = (st >> 1) * 16 + swz / 64; C = (st & 1) * 32 + (swz % 64) / 2; }
__host__ __device__ __forceinline__ int perm32(int rho) { const int n = rho >> 4, i = rho & 15; return 8 * (i >> 2) + 4 * n + (i & 3); }
struct Unit { int pm, pn; };
struct Gemm { const bf16_t* A; const bf16_t* Bt; int M, N, K; };
struct StaticOrder {
    int nM, nN, nwg, G, c;
    __host__ __device__ void init(int M, int N, int G_, int c_) { nM = M / BM; nN = N / BM; nwg = nM * nN; G = G_; c = c_; }
    __host__ __device__ bool next(int i, Unit& u) const {
        const long L = (long)i * G + c; if (L >= nwg) return false;
        int wgid = (int)L; { const int q = nwg / NXCD, r = nwg % NXCD, xcd = wgid % NXCD, off = wgid / NXCD; wgid = (xcd < r ? xcd * (q + 1) : r * (q + 1) + (xcd - r) * q) + off; }
        const int nig = WGM * nN, gid = wgid / nig, fm = gid * WGM, gsz = (nM - fm) < WGM ? (nM - fm) : WGM;
        u.pm = fm + ((wgid % nig) % gsz); u.pn = (wgid % nig) / gsz; return true;
    }
    __device__ __forceinline__ void a_ready(const Unit&) const {}
    __device__ __forceinline__ void done(const Unit&) const {}
};
template <class Epi, class Sched>
__device__ __forceinline__ void gemm_phase(PG8_LAS unsigned char* lds, const Gemm g, const Sched& S, const Epi& E, const int tid) {
    const int wid = __builtin_amdgcn_readfirstlane(tid >> 6), lane = tid & 63, wr = wid >> 2, wc = wid & 3, fr = lane & 15, fq = lane >> 4;
    const int K = g.K, nt = K / BK;
#define PG8_STAMP() do { } while (0)
    unsigned voffA[2], voffB[2];
#pragma unroll
    for (int i = 0; i < 2; ++i) { int R, C; stage_rc(tid * 16 + i * 8192, R, C); const int Rb = Epi::PERM ? ((R & ~31) + perm32(R & 31)) : R;
        voffA[i] = (unsigned)(R * K + C) * 2u; voffB[i] = (unsigned)(Rb * K + C) * 2u; }
    const size_t kstep = (size_t)(BK * 2);
    const size_t hstep = (size_t)HALF * K * 2;
    const size_t tstep = 2 * hstep;
    const unsigned ldsw = (unsigned)wid * 1024u;
    const int aoff = lds_byte(wr * 64 + fr, fq * 8), boff = lds_byte(wc * 32 + fr, fq * 8);
#define PG8_SA(b, h) (((b) * 2 + (h)) * HTB)
#define PG8_SB(b, h) ((4 + (b) * 2 + (h)) * HTB)
#define PG8_STAGE(bufoff, gbase, voff) do { _Pragma("unroll") for (int _i = 0; _i < 2; ++_i) \
        __builtin_amdgcn_global_load_lds((const unsigned*)((const char*)(gbase) + (voff)[_i]), (PG8_LAS unsigned*)(lds + (bufoff) + ldsw + _i * 8192), 16, 0, 0); } while (0)
#define PG8_LDA(dst, b, h) do { _Pragma("unroll") for (int m = 0; m < 4; ++m) _Pragma("unroll") for (int k = 0; k < 2; ++k) dst[m][k] = *(const PG8_LAS bf16x8*)(lds + PG8_SA(b, h) + aoff + m * 2048 + k * 1024); } while (0)
#define PG8_LDB(dst, b, h) do { _Pragma("unroll") for (int n = 0; n < 2; ++n) _Pragma("unroll") for (int k = 0; k < 2; ++k) dst[n][k] = *(const PG8_LAS bf16x8*)(lds + PG8_SB(b, h) + boff + n * 2048 + k * 1024); } while (0)
#define PG8_MMA(ai, bj, At, Bt) do { __builtin_amdgcn_s_setprio(1); _Pragma("unroll") for (int m = 0; m < 4; ++m) _Pragma("unroll") for (int n = 0; n < 2; ++n) _Pragma("unroll") for (int k = 0; k < 2; ++k) \
        acc[ai][bj][m][n] = __builtin_amdgcn_mfma_f32_16x16x32_bf16(Bt[n][k], At[m][k], acc[ai][bj][m][n], 0, 0, 0); __builtin_amdgcn_s_setprio(0); } while (0)
#define PG8_WAIT_V(n) asm volatile("s_waitcnt vmcnt(" #n ")" ::: "memory")
#define PG8_WAIT_L(n) asm volatile("s_waitcnt lgkmcnt(" #n ")" ::: "memory")
#define PG8_BAR __builtin_amdgcn_s_barrier()
#define PG8_SCHED __builtin_amdgcn_sched_barrier(0)
    Unit cur, nxt; int ui = 0;
    if (!S.next(0, cur)) return;
    f32x4 acc[2][2][4][2];
#pragma unroll
    for (int a = 0; a < 2; ++a)
#pragma unroll
        for (int b = 0; b < 2; ++b)
#pragma unroll
            for (int m = 0; m < 4; ++m)
#pragma unroll
                for (int n = 0; n < 2; ++n) acc[a][b][m][n] = (f32x4){0.f, 0.f, 0.f, 0.f};
    bf16x8 At[4][2], B0[2][2], B1[2][2];
    const char* cA = (const char*)g.A + (size_t)cur.pm * tstep; const char* cB = (const char*)g.Bt + (size_t)cur.pn * tstep;
    S.a_ready(cur);
    PG8_STAGE(PG8_SB(0, 0), cB, voffB); PG8_STAGE(PG8_SA(0, 0), cA, voffA); PG8_STAGE(PG8_SB(0, 1), cB + hstep, voffB); PG8_STAGE(PG8_SA(0, 1), cA + hstep, voffA);
    if (wr == 1) PG8_BAR;
    PG8_WAIT_V(4); PG8_BAR;
    PG8_STAGE(PG8_SB(1, 0), cB + kstep, voffB); PG8_STAGE(PG8_SA(1, 0), cA + kstep, voffA); PG8_STAGE(PG8_SB(1, 1), cB + hstep + kstep, voffB);
    PG8_WAIT_V(6); PG8_BAR;
    PG8_STAMP();
    for (;;) {
        const bool has_next = S.next(ui + 1, nxt);
        const char* nA = has_next ? (const char*)g.A + (size_t)nxt.pm * tstep : cA; const char* nB = has_next ? (const char*)g.Bt + (size_t)nxt.pn * tstep : cB;
        for (int t = 0; t < nt; t += 2) {
            const bool last = (t == nt - 2);
            const char* a1 = cA + (size_t)(t + 1) * kstep;
            const char* a2 = last ? nA : cA + (size_t)(t + 2) * kstep; const char* b2 = last ? nB : cB + (size_t)(t + 2) * kstep;
            const char* a3 = a2 + kstep; const char* b3 = b2 + kstep;
            if (last && has_next) S.a_ready(nxt);
            PG8_LDB(B0, 0, 0); PG8_SCHED; PG8_LDA(At, 0, 0); PG8_STAGE(PG8_SA(1, 1), a1 + hstep, voffA);
            PG8_WAIT_L(8); PG8_BAR; PG8_WAIT_L(0); PG8_MMA(0, 0, At, B0); PG8_BAR; PG8_SCHED;
            PG8_LDB(B1, 0, 1); PG8_STAGE(PG8_SB(0, 0), b2, voffB);
            PG8_BAR; PG8_WAIT_L(0); PG8_MMA(0, 1, At, B1); PG8_BAR;
            PG8_LDA(At, 0, 1); PG8_STAGE(PG8_SA(0, 0), a2, voffA);
            PG8_BAR; PG8_WAIT_L(0); PG8_MMA(1, 0, At, B0); PG8_BAR; PG8_SCHED;
            PG8_STAGE(PG8_SB(0, 1), b2 + hstep, voffB);
            PG8_WAIT_V(6); PG8_BAR; PG8_MMA(1, 1, At, B1); PG8_BAR;
            PG8_LDB(B0, 1, 0); PG8_SCHED; PG8_LDA(At, 1, 0); PG8_STAGE(PG8_SA(0, 1), a2 + hstep, voffA);
            PG8_WAIT_L(8); PG8_BAR; PG8_WAIT_L(0); PG8_MMA(0, 0, At, B0); PG8_BAR; PG8_SCHED;
            PG8_LDB(B1, 1, 1); PG8_STAGE(PG8_SB(1, 0), b3, voffB);
            PG8_BAR; PG8_WAIT_L(0); PG8_MMA(0, 1, At, B1); PG8_BAR;
            PG8_LDA(At, 1, 1); PG8_STAGE(PG8_SA(1, 0), a3, voffA);
            PG8_BAR; PG8_WAIT_L(0); PG8_MMA(1, 0, At, B0); PG8_BAR; PG8_SCHED;
            PG8_STAGE(PG8_SB(1, 1), b3 + hstep, voffB);
            PG8_WAIT_V(6); PG8_BAR; PG8_MMA(1, 1, At, B1); PG8_BAR;
        }
        PG8_STAMP();
        if constexpr (!Epi::AFTER_DRAIN) { E(acc, cur, wr, wc, fr, fq, ui); S.done(cur); }
        PG8_STAMP();
        if (!has_next) break;
#pragma unroll
        for (int a = 0; a < 2; ++a)
#pragma unroll
            for (int b = 0; b < 2; ++b)
#pragma unroll
                for (int m = 0; m < 4; ++m)
#pragma unroll
                    for (int n = 0; n < 2; ++n) acc[a][b][m][n] = (f32x4){0.f, 0.f, 0.f, 0.f};
        cur = nxt; cA = nA; cB = nB; ++ui;
    }
    PG8_WAIT_V(0);
    if (wr == 0) PG8_BAR;
    PG8_BAR;
#undef PG8_STAMP
#undef PG8_SA
#undef PG8_SB
#undef PG8_STAGE
#undef PG8_LDA
#undef PG8_LDB
#undef PG8_MMA
#undef PG8_WAIT_V
#undef PG8_WAIT_L
#undef PG8_BAR
#undef PG8_SCHED
}
}
using pg8::Unit;
DI void rstd_prepass(LAS float* tab, const float* ss, const pg8::StaticOrder& S, int tid) {
    const int w8 = __builtin_amdgcn_readfirstlane(tid >> 8), r = tid & 255;
    f32x4 a[9][4]; bool ok[9];
#pragma unroll
    for (int j = 0; j < 9; ++j) { Unit u; ok[j] = S.next(w8 + 2 * j, u);
        if (ok[j]) { const f32x4* q = (const f32x4*)(ss + (size_t)(u.pm * 256 + r) * 16); a[j][0] = q[0]; a[j][1] = q[1]; a[j][2] = q[2]; a[j][3] = q[3]; } }
#pragma unroll
    for (int j = 0; j < 9; ++j) if (ok[j]) {
        const float v = ((a[j][0].x + a[j][0].y) + (a[j][0].z + a[j][0].w)) + ((a[j][1].x + a[j][1].y) + (a[j][1].z + a[j][1].w)) + ((a[j][2].x + a[j][2].y) + (a[j][2].z + a[j][2].w)) + ((a[j][3].x + a[j][3].y) + (a[j][3].z + a[j][3].w));
        tab[(w8 + 2 * j) * 256 + r] = rsqrtf(v * (1.0f / DM) + EPS); }
    __syncthreads();
}

struct EpiSwiglu {
    static constexpr bool PERM = true, AFTER_DRAIN = false;
    bf16_t* act; LAS float* tab;
    DI void operator()(const f32x4 (&acc)[2][2][4][2], const Unit& u, int wr, int wc, int fr, int fq, int ui) const {
        const int row0 = u.pm * 256 + wr * 64 + fr, col0 = u.pn * 128 + wc * 32 + 8 * fq;
#pragma unroll
        for (int ai = 0; ai < 2; ++ai)
#pragma unroll
            for (int m = 0; m < 4; ++m) {
                const int row = row0 + ai * 128 + m * 16;
                const float rstd = tab[ui * 256 + wr * 64 + fr + ai * 128 + m * 16];
                float o[8];
#pragma unroll
                for (int n = 0; n < 2; ++n)
#pragma unroll
                    for (int j = 0; j < 4; ++j) { const float gv = acc[ai][0][m][n][j] * rstd, uv = acc[ai][1][m][n][j] * rstd; o[4 * n + j] = silu_f(gv) * uv; }
                u32x4 pk = {pk2(o[0], o[1]), pk2(o[2], o[3]), pk2(o[4], o[5]), pk2(o[6], o[7])};
                __builtin_nontemporal_store(pk, (u32x4*)(act + (size_t)row * FF + col0));
            }
    }
};
struct EpiResid {
    static constexpr bool PERM = true, AFTER_DRAIN = false;
    bf16_t* xb; float* ssout; float scale;
    DI void operator()(const f32x4 (&acc)[2][2][4][2], const Unit& u, int wr, int wc, int fr, int fq, int ui) const {
        const int row0 = u.pm * 256 + wr * 64 + fr, col0 = u.pn * 256 + wc * 32 + 8 * fq;
#pragma unroll
        for (int ai = 0; ai < 2; ++ai)
#pragma unroll
            for (int m = 0; m < 4; ++m) {
                const int row = row0 + ai * 128 + m * 16;
                bf16_t* xo = xb + (size_t)row * DM + col0;
                float sq = 0.f;
#pragma unroll
                for (int bj = 0; bj < 2; ++bj) {
                    const u32x4 o = *(const u32x4*)(xo + bj * 128);
                    const f32x4 o0 = {bflo(o.x), bfhi(o.x), bflo(o.y), bfhi(o.y)}, o1 = {bflo(o.z), bfhi(o.z), bflo(o.w), bfhi(o.w)};
                    const f32x4 v0 = o0 + acc[ai][bj][m][0] * scale, v1 = o1 + acc[ai][bj][m][1] * scale;
                    *(u32x4*)(xo + bj * 128) = (u32x4){pk2(v0.x, v0.y), pk2(v0.z, v0.w), pk2(v1.x, v1.y), pk2(v1.z, v1.w)};
                    sq += (v0.x * v0.x + v0.y * v0.y) + (v0.z * v0.z + v0.w * v0.w) + (v1.x * v1.x + v1.y * v1.y) + (v1.z * v1.z + v1.w * v1.w);
                }
                sq += __shfl_xor(sq, 16); sq += __shfl_xor(sq, 32);
                if (fq == 0) ssout[(size_t)row * 16 + u.pn * 4 + wc] = sq;
            }
    }
};
struct EpiFinal {
    static constexpr bool PERM = true, AFTER_DRAIN = false;
    float* xout; const bf16_t* xb; float* ss; const float* gain;
    DI void operator()(f32x4 (&acc)[2][2][4][2], const Unit& u, int wr, int wc, int fr, int fq, int ui) const {
        const int row0 = u.pm * 256 + wr * 64 + fr, col0 = u.pn * 256 + wc * 32 + 8 * fq;
#pragma unroll
        for (int ai = 0; ai < 2; ++ai)
#pragma unroll
            for (int m = 0; m < 4; ++m) {
                const int row = row0 + ai * 128 + m * 16;
                const bf16_t* xo = xb + (size_t)row * DM + col0;
                float sq = 0.f;
#pragma unroll
                for (int bj = 0; bj < 2; ++bj) {
                    const u32x4 o = *(const u32x4*)(xo + bj * 128);
                    const f32x4 o0 = {bflo(o.x), bfhi(o.x), bflo(o.y), bfhi(o.y)}, o1 = {bflo(o.z), bfhi(o.z), bflo(o.w), bfhi(o.w)};
                    const f32x4 v0 = o0 + acc[ai][bj][m][0] * 0.5f, v1 = o1 + acc[ai][bj][m][1] * 0.5f;
                    acc[ai][bj][m][0] = v0; acc[ai][bj][m][1] = v1;
                    sq += (v0.x * v0.x + v0.y * v0.y) + (v0.z * v0.z + v0.w * v0.w) + (v1.x * v1.x + v1.y * v1.y) + (v1.z * v1.z + v1.w * v1.w);
                }
                sq += __shfl_xor(sq, 16); sq += __shfl_xor(sq, 32);
                if (fq == 0) __hip_atomic_store(ss + (size_t)row * 16 + u.pn * 4 + wc, sq, __ATOMIC_RELAXED, __HIP_MEMORY_SCOPE_AGENT);
            }
        f32x4 g[2][2];
#pragma unroll
        for (int bj = 0; bj < 2; ++bj) { g[bj][0] = *(const f32x4*)(gain + col0 + bj * 128); g[bj][1] = *(const f32x4*)(gain + col0 + bj * 128 + 4); }
        unsigned spins = 0;
#pragma unroll
        for (int ai = 0; ai < 2; ++ai)
#pragma unroll
            for (int m = 0; m < 4; ++m) {
                const int row = row0 + ai * 128 + m * 16;
                float* sl = ss + (size_t)row * 16 + 4 * fq;
                float a, b, c, d;
                for (;;) {
                    a = __hip_atomic_load(sl, __ATOMIC_RELAXED, __HIP_MEMORY_SCOPE_AGENT); b = __hip_atomic_load(sl + 1, __ATOMIC_RELAXED, __HIP_MEMORY_SCOPE_AGENT);
                    c = __hip_atomic_load(sl + 2, __ATOMIC_RELAXED, __HIP_MEMORY_SCOPE_AGENT); d = __hip_atomic_load(sl + 3, __ATOMIC_RELAXED, __HIP_MEMORY_SCOPE_AGENT);
                    const bool nr = (a < 0.f) || (b < 0.f) || (c < 0.f) || (d < 0.f);
                    if (__builtin_amdgcn_ballot_w64(nr) == 0ull || ++spins > (1u << 20)) break;
                    __builtin_amdgcn_s_sleep(1);
                }
                float s = (a + b) + (c + d);
                s += __shfl_xor(s, 16); s += __shfl_xor(s, 32);
                const float rstd = rsqrtf(s * (1.0f / DM) + EPS);
                float* xo = xout + (size_t)row * DM + col0;
#pragma unroll
                for (int bj = 0; bj < 2; ++bj) { __builtin_nontemporal_store(acc[ai][bj][m][0] * rstd * g[bj][0], (f32x4*)(xo + bj * 128)); __builtin_nontemporal_store(acc[ai][bj][m][1] * rstd * g[bj][1], (f32x4*)(xo + bj * 128 + 4)); }
            }
    }
};
struct EpiInProj {
    static constexpr bool PERM = true, AFTER_DRAIN = false;
    unsigned char* ws; LAS float* tab;
    DI void operator()(const f32x4 (&acc)[2][2][4][2], const Unit& u, int wr, int wc, int fr, int fq, int ui) const {
        const int row0 = u.pm * 256 + wr * 64 + fr, t = u.pn;
        const LAS float* tb = tab + ui * 256 + wr * 64 + fr;
        if (t <= 2) {
            const float* cosT = (const float*)(ws + OFF_ROPE); const float* sinT = cosT + 8192 * 32;
            const bool rot = (t < 2) || (wc < 2);
            bf16_t* base; int ld;
            if (t < 2) { base = (bf16_t*)(ws + OFF_Q) + (t * 4 + wc) * 64; ld = 512; }
            else if (wc < 2) { base = (bf16_t*)(ws + OFF_K) + wc * 64; ld = 128; }
            else { base = (bf16_t*)(ws + OFF_V) + (wc - 2) * 64; ld = 128; }
#pragma unroll
            for (int ai = 0; ai < 2; ++ai)
#pragma unroll
                for (int m = 0; m < 4; ++m) {
                    const int row = row0 + ai * 128 + m * 16;
                    const float rstd = tb[ai * 128 + m * 16];
                    const int pos = row < MP ? (row & 2047) : (row & 8191);
                    const float sc = (t < 2) ? (0.125f * LOG2E) * rstd : rstd;
                    bf16_t* dst = base + (size_t)row * ld + 8 * fq;
#pragma unroll
                    for (int n = 0; n < 2; ++n) {
                        f32x4 cs = {1.f, 1.f, 1.f, 1.f}, sn = {0.f, 0.f, 0.f, 0.f};
                        if (rot) { cs = *(const f32x4*)(cosT + pos * 32 + 8 * fq + 4 * n); sn = *(const f32x4*)(sinT + pos * 32 + 8 * fq + 4 * n); }
                        const f32x4 x1 = acc[ai][0][m][n] * sc, x2 = acc[ai][1][m][n] * sc;
                        const f32x4 o1 = x1 * cs - x2 * sn, o2 = x2 * cs + x1 * sn;
                        *(u32x2*)(dst + 4 * n) = (u32x2){pk2(o1.x, o1.y), pk2(o1.z, o1.w)};
                        *(u32x2*)(dst + 32 + 4 * n) = (u32x2){pk2(o2.x, o2.y), pk2(o2.z, o2.w)};
                    }
                }
        } else if (t <= 8) {
            bf16_t* base; int ld; float sc = 1.0f;
            if (t == 3) { base = (bf16_t*)(ws + OFF_GQ); ld = 256; sc = 0.125f; }
            else if (t == 4) { base = (bf16_t*)(ws + OFF_GK); ld = 256; }
            else if (t <= 6) { base = (bf16_t*)(ws + OFF_GV) + (t - 5) * 256; ld = 512; }
            else { base = (bf16_t*)(ws + OFF_SG) + (t - 7) * 256; ld = 512; }
            const bool act = t >= 7;
#pragma unroll
            for (int ai = 0; ai < 2; ++ai)
#pragma unroll
                for (int m = 0; m < 4; ++m) {
                    const int row = row0 + ai * 128 + m * 16;
                    const float rstd = tb[ai * 128 + m * 16] * sc;
                    bf16_t* dst = base + (size_t)row * ld + wc * 32 + 8 * fq;
#pragma unroll
                    for (int bj = 0; bj < 2; ++bj) {
                        f32x4 v0 = acc[ai][bj][m][0] * rstd, v1 = acc[ai][bj][m][1] * rstd;
                        if (act) {
#pragma unroll
                            for (int j = 0; j < 4; ++j) { v0[j] = silu_f(v0[j]); v1[j] = silu_f(v1[j]); } }
                        *(u32x4*)(dst + bj * 128) = (u32x4){pk2(v0.x, v0.y), pk2(v0.z, v0.w), pk2(v1.x, v1.y), pk2(v1.z, v1.w)};
                    }
                }
        }
    }
};
DI void p0_item(const float* src, int ld, int col0, bool zero, const float* gain, bf16_t* dst, int K, int p0, int k0, LAS float* scr, int lane) {
    const int kr = lane >> 3, n4 = (lane & 7) * 4;
    f32x4 w[8];
#pragma unroll
    for (int i = 0; i < 8; ++i) w[i] = zero ? (f32x4){0.f, 0.f, 0.f, 0.f} : __builtin_nontemporal_load((const f32x4*)(src + (size_t)(k0 + 8 * i + kr) * ld + col0 + n4));
    if (gain) {
#pragma unroll
        for (int i = 0; i < 8; ++i) w[i] = w[i] * gain[k0 + 8 * i + kr]; }
#pragma unroll
    for (int i = 0; i < 8; ++i) { LAS float* d = scr + (8 * i + kr) * 33 + n4; d[0] = w[i].x; d[1] = w[i].y; d[2] = w[i].z; d[3] = w[i].w; }
    lds_wait();
    const int c = lane & 7;
#pragma unroll
    for (int j = 0; j < 4; ++j) { const int n = (lane >> 3) + 8 * j; const LAS float* s = scr + (8 * c) * 33 + n;
        u32x4 o = {pk2(s[0], s[33]), pk2(s[66], s[99]), pk2(s[132], s[165]), pk2(s[198], s[231])};
        *(u32x4*)(dst + (size_t)(p0 + n) * K + k0 + 8 * c) = o; }
    lds_wait();
}
DI void p0_weights(const Params& p, LAS unsigned char* lds, int tid, int gw, int NGW, int lo, int hi) {
    const int wave = tid >> 6, lane = tid & 63; unsigned char* ws = p.ws;
    LAS float* scr = (LAS float*)(lds + wave * 8448);
    for (int it = lo + gw; it < hi; it += NGW) {
        int r = it, mat;
        if (r < 2816) mat = 0; else if ((r -= 2816) < 1408) mat = 1; else if ((r -= 1408) < 1152) mat = 2; else if ((r -= 1152) < 512) mat = 3; else if ((r -= 512) < 2816) mat = 4; else { r -= 2816; mat = 5; }
        if (mat == 0 || mat == 4) {
            const int kb = r / 176, pg = r % 176, pp = pg * 32, pn = pp >> 8, bj = (pp >> 7) & 1, cc = pp & 127;
            const float* src = p.in[mat == 0 ? (bj ? 4 : 3) : (bj ? 17 : 16)];
            p0_item(src, FF, 128 * pn + cc, false, p.in[mat == 0 ? 2 : 15], (bf16_t*)(ws + (mat == 0 ? OFF_WGU1 : OFF_WGU2)), DM, pp, kb * 64, scr, lane);
        } else if (mat == 1 || mat == 5) {
            const int kb = r / 32, pg = r % 32;
            p0_item(p.in[mat == 1 ? 5 : 18], DM, pg * 32, false, nullptr, (bf16_t*)(ws + (mat == 1 ? OFF_WD1 : OFF_WD2)), FF, pg * 32, kb * 64, scr, lane);
        } else if (mat == 2) {
            const int kb = r / 72, pg = r % 72, pp = pg * 32, t = pp >> 8, qq = pp & 255;
            int col; const bool zero = false;
            if (t <= 2) col = 256 * t + 64 * ((qq & 127) >> 5) + 32 * (qq >> 7);
            else col = pp;
            p0_item(p.in[7], NINL, col, zero, p.in[6], (bf16_t*)(ws + OFF_WIN), DM, pp, kb * 64, scr, lane);
        } else {
            const int kb = r / 32, pg = r % 32;
            p0_item(p.in[14], DM, pg * 32, false, nullptr, (bf16_t*)(ws + OFF_WOUT), DM, pg * 32, kb * 64, scr, lane);
        }
    }
}
DI void p0_prologue(const Params& p, LAS unsigned char* lds, int tid, int G, int bid) {
    const int wave = tid >> 6, lane = tid & 63, gw = bid * 8 + wave, NGW = G * 8;
    unsigned char* ws = p.ws;
    p0_weights(p, lds, tid, gw, NGW, 0, 2816);
    bf16_t* xb = (bf16_t*)(ws + OFF_XB); float* ss0 = (float*)(ws + OFF_SS);
    for (int row0 = gw; row0 < M_TOK; row0 += 4 * NGW) {
        f32x4 v[4][4]; bool has[4];
#pragma unroll
        for (int q = 0; q < 4; ++q) { const int row = row0 + q * NGW; has[q] = row < M_TOK; const int rc = has[q] ? row : row0;
            const float* xr = rc < MP ? p.in[0] + (size_t)rc * DM : p.in[1] + (size_t)(rc - MP) * DM;
#pragma unroll
            for (int j = 0; j < 4; ++j) v[q][j] = __builtin_nontemporal_load((const f32x4*)(xr + 256 * j + 4 * lane)); }
#pragma unroll
        for (int q = 0; q < 4; ++q) { const int row = row0 + q * NGW;
            float s = 0.f;
#pragma unroll
            for (int j = 0; j < 4; ++j) s += (v[q][j].x * v[q][j].x + v[q][j].y * v[q][j].y) + (v[q][j].z * v[q][j].z + v[q][j].w * v[q][j].w);
#pragma unroll
            for (int o = 1; o < 64; o <<= 1) s += __shfl_xor(s, o);
            if (has[q]) {
#pragma unroll
                for (int j = 0; j < 4; ++j) *(u32x2*)(xb + (size_t)row * DM + 256 * j + 4 * lane) = (u32x2){pk2(v[q][j].x, v[q][j].y), pk2(v[q][j].z, v[q][j].w)};
                if (lane < 16) ss0[(size_t)row * 16 + lane] = lane == 0 ? s : 0.f;
            }
        }
    }
    if (bid == 0) { unsigned* bw = (unsigned*)(ws + OFF_BAR); for (int i = tid; i < XCD_BAR_WORDS; i += 512) bw[i] = 0u; }
    { float* ss3 = (float*)(ws + OFF_SS + 3 * SS_BYTES); for (int i = bid * 512 + tid; i < M_TOK * 4; i += G * 512) ((f32x4*)ss3)[i] = (f32x4){-1.f, -1.f, -1.f, -1.f}; }
    {
        bf16_t* wrf = (bf16_t*)(ws + OFF_WRF);
        for (int idx = bid * 512 + tid; idx < 32768; idx += G * 512) { const int k = idx >> 5, col = idx & 31;
            const float w = p.in[7][(size_t)k * NINL + 2304 + col] * p.in[6][k];
            wrf[(((k >> 4) * 64) + ((k >> 3) & 1) * 32 + col) * 8 + (k & 7)] = (bf16_t)(pk2(w, 0.f) & 0xffffu); }
    }
    {
        float* sm = (float*)(ws + OFF_SMALL);
        for (int i = bid * 512 + tid; i < SM_TOTAL; i += G * 512) {
            float v = 0.f;
            if (i < SM_WDF) { if (i < 8) v = p.in[8][i]; }
            else if (i < SM_BDF) v = p.in[9][i - SM_WDF];
            else if (i < SM_WDB) v = p.in[10][i - SM_BDF];
            else if (i < SM_BDB) v = p.in[11][i - SM_WDB];
            else if (i < SM_GN) v = p.in[12][i - SM_BDB];
            else if (i < SM_NF) v = p.in[13][i - SM_GN];
            else v = p.in[19][i - SM_NF];
            sm[i] = v;
        }
    }
    float* cosT = (float*)(ws + OFF_ROPE); float* sinT = cosT + 8192 * 32;
    for (int idx = bid * 512 + tid; idx < 8192 * 32; idx += G * 512) {
        const int t = idx >> 5, i = idx & 31;
        const float inv = (float)exp2(-(double)i * (13.287712379549449 / 32.0));
        const float ang = (float)t * inv;
        const double rev = (double)ang * 0.15915494309189535; const double fr = rev - rint(rev);
        const float a = (float)(fr * 6.283185307179586);
        cosT[idx] = cosf(a); sinT[idx] = sinf(a);
    }
}

DI void attn_unit(unsigned char* ws, LAS unsigned char* lds, int unit, int tid) {
    asm volatile("" : "+v"(tid));
    const int wave = tid >> 6, lane = tid & 63, r = lane & 31, h = lane >> 5, q4 = (lane & 15) >> 2, p4 = lane & 3, blk = (lane >> 4) & 1;
    const int qblk = unit >> 1, hk = unit & 1, row0 = qblk * 128;
    const int T = row0 < MP ? 2048 : 8192, pos0 = row0 & (T - 1);
    const int jmin = pos0 == 0 ? 128 : 0, jmax = (pos0 + 128 == T) ? 256 : 384;
    const bf16_t* qr = (const bf16_t*)(ws + OFF_Q); const bf16_t* kr = (const bf16_t*)(ws + OFF_K); const bf16_t* vr = (const bf16_t*)(ws + OFF_V);
    bf16_t* mix = (bf16_t*)(ws + OFF_MIX);
    LAS unsigned char* Kl = lds; LAS unsigned char* Vl = lds + 384 * 144;
    const int g = wave >> 1, half = wave & 1, head = hk * 4 + g;
    const float sinkl = ((const float*)(ws + OFF_SMALL))[SM_SINK + head] * LOG2E;
    bf16x8 qf[2][4];
#pragma unroll
    for (int qb = 0; qb < 2; ++qb)
#pragma unroll
        for (int s = 0; s < 4; ++s) qf[qb][s] = *(const bf16x8*)(qr + (size_t)(row0 + 64 * half + 32 * qb + r) * 512 + head * 64 + 16 * s + 8 * h);
    {
        u32x4 st[12];
#pragma unroll
        for (int i = 0; i < 12; ++i) { const int e = tid + 512 * i, which = i >= 6, f = which ? e - 3072 : e, j = f >> 3, c = f & 7;
            st[i] = (u32x4){0u, 0u, 0u, 0u};
            if (j >= jmin && j < jmax) st[i] = *(const u32x4*)((which ? vr : kr) + (size_t)(row0 - 128 + j) * 128 + hk * 64 + c * 8); }
#pragma unroll
        for (int i = 0; i < 12; ++i) { const int e = tid + 512 * i, which = i >= 6, f = which ? e - 3072 : e, j = f >> 3, c = f & 7;
            *(LAS u32x4*)((which ? Vl : Kl) + j * 144 + c * 16) = st[i]; }
    }
    __syncthreads();
    f32x16 o[2][2];
#pragma unroll
    for (int a = 0; a < 2; ++a)
#pragma unroll
        for (int b = 0; b < 2; ++b)
#pragma unroll
            for (int i = 0; i < 16; ++i) o[a][b][i] = 0.f;
    float mrun[2] = {sinkl, sinkl}, lrun[2] = {h == 0 ? 1.f : 0.f, h == 0 ? 1.f : 0.f};
    const bool seqedge = (jmin != 0) || (jmax != 384);
    bf16x8 kf[4], vf[2][2];
#define ATT_LOAD(KF, VF, KB) do { _Pragma("unroll") for (int s = 0; s < 4; ++s) KF[s] = *(const LAS bf16x8*)(Kl + (32 * (KB) + r) * 144 + (16 * s + 8 * h) * 2); \
        _Pragma("unroll") for (int db = 0; db < 2; ++db) _Pragma("unroll") for (int s2 = 0; s2 < 2; ++s2) { LAS unsigned char* a_ = Vl + (32 * (KB) + 16 * s2 + 4 * h + q4) * 144 + (32 * db + 16 * blk + 4 * p4) * 2; \
            VF[db][s2] = cat8(trr(a_), trr(a_ + 8 * 144)); } } while (0)
    ATT_LOAD(kf, vf, 2 * half);
#pragma unroll 2
    for (int kb = 2 * half; kb < 2 * half + 10; ++kb) {
        bf16x8 kfn[4], vfn[2][2];
        { const int kn = kb + 1 < 12 ? kb + 1 : 11; ATT_LOAD(kfn, vfn, kn); }
#pragma unroll
        for (int qb = 0; qb < 2; ++qb) {
            const int qd = kb - (2 * half + qb);
            if (qd < 0 || qd > 8) continue;
            f32x16 x;
#pragma unroll
            for (int i = 0; i < 16; ++i) x[i] = 0.f;
#pragma unroll
            for (int s = 0; s < 4; ++s) x = MFMA32(kf[s], qf[qb][s], x);
            float bm = -1e30f;
            if (qd == 0 || qd == 8 || seqedge) {
                const int qi = 64 * half + 32 * qb + r, base = 32 * kb + 4 * h;
                const int lo = max(qi, jmin) - base, hi = min(qi + 256, jmax - 1) - base;
#pragma unroll
                for (int i = 0; i < 16; ++i) { const int c = (i & 3) + 8 * (i >> 2);
                    x[i] = (c >= lo && c <= hi) ? x[i] : -1e30f; bm = fmaxf(bm, x[i]); }
            } else {
#pragma unroll
                for (int i = 0; i < 16; ++i) bm = fmaxf(bm, x[i]);
            }
            bm = xh_max(bm);
            const float mo = mrun[qb], mn = fmaxf(mo, bm);
            mrun[qb] = mn;
            float ps = 0.f;
#pragma unroll
            for (int i = 0; i < 16; ++i) { x[i] = __builtin_amdgcn_exp2f(x[i] - mn); ps += x[i]; }
            if (__builtin_amdgcn_ballot_w64(mn > mo) != 0ull) {
                const float alpha = __builtin_amdgcn_exp2f(mo - mn);
                lrun[qb] *= alpha;
#pragma unroll
                for (int db = 0; db < 2; ++db)
#pragma unroll
                    for (int i = 0; i < 16; ++i) o[qb][db][i] *= alpha;
            }
            lrun[qb] += ps;
            const bf16x8 pk0 = pack8(x[0], x[1], x[2], x[3], x[4], x[5], x[6], x[7]), pk1 = pack8(x[8], x[9], x[10], x[11], x[12], x[13], x[14], x[15]);
#pragma unroll
            for (int db = 0; db < 2; ++db) { o[qb][db] = MFMA32(vf[db][0], pk0, o[qb][db]); o[qb][db] = MFMA32(vf[db][1], pk1, o[qb][db]); }
        }
#pragma unroll
        for (int s = 0; s < 4; ++s) kf[s] = kfn[s];
#pragma unroll
        for (int db = 0; db < 2; ++db) { vf[db][0] = vfn[db][0]; vf[db][1] = vfn[db][1]; }
    }
#undef ATT_LOAD
#pragma unroll
    for (int qb = 0; qb < 2; ++qb) {
        const float lt = xh_sum(lrun[qb]), inv = 1.0f / lt;
        bf16_t* dst = mix + (size_t)(row0 + 64 * half + 32 * qb + r) * DM + head * 64 + 8 * h;
#pragma unroll
        for (int db = 0; db < 2; ++db)
#pragma unroll
            for (int g2 = 0; g2 < 2; ++g2) {
                const u32x2 wa = {pk2(o[qb][db][8 * g2] * inv, o[qb][db][8 * g2 + 1] * inv), pk2(o[qb][db][8 * g2 + 2] * inv, o[qb][db][8 * g2 + 3] * inv)};
                const u32x2 wb = {pk2(o[qb][db][8 * g2 + 4] * inv, o[qb][db][8 * g2 + 5] * inv), pk2(o[qb][db][8 * g2 + 6] * inv, o[qb][db][8 * g2 + 7] * inv)};
                *(u32x4*)(dst + 32 * db + 16 * g2) = widen_pair(wa, wb); }
    }
    __syncthreads();
}
constexpr int GL_RF = 0, GL_TOT = 8192, GL_VIM = 12288, GL_EIM = 47104, VIM_ST = 544, EIM_ST = 144;
DI float logsig(float z) { return fminf(z, 0.f) - __logf(1.0f + __expf(-fabsf(z))); }
DI float logsig2(float z) { const float zl = z * LOG2E; return fminf(zl, 0.f) - __builtin_amdgcn_logf(1.0f + __builtin_amdgcn_exp2f(-fabsf(zl))); }
typedef unsigned short u16x2 __attribute__((ext_vector_type(2)));
struct GlaPre { u16x2 kq[16]; f32x4 rf; u32x4 vst[4]; };
template <int PASS> DI void gla_load(GlaPre& P, unsigned char* ws, int unit, int tid) {
    const int wave = tid >> 6, lane = tid & 63, gc = unit >> 1, hp = unit & 1, row0 = gc * 64;
    const bf16_t* gq = (const bf16_t*)(ws + OFF_GQ); const bf16_t* gk = (const bf16_t*)(ws + OFF_GK); const bf16_t* gv = (const bf16_t*)(ws + OFF_GV); const float* rr = (const float*)(ws + OFF_RR);
    const int ch = (hp * 2 + (wave >> 2)) * 64 + lane;
    const bf16_t* kp = gk + (size_t)(row0 + (wave & 3) * 16) * 256 + ch; const bf16_t* qp = gq + (size_t)(row0 + (wave & 3) * 16) * 256 + ch;
#pragma unroll
    for (int t = 0; t < 16; ++t) { u16x2 v; v.x = kp[(size_t)t * 256]; v.y = (PASS == 1) ? qp[(size_t)t * 256] : (unsigned short)0; P.kq[t] = v; }
    P.rf = *(const f32x4*)(rr + (size_t)(row0 + (tid >> 3)) * 32 + (tid & 7) * 4);
#pragma unroll
    for (int i = 0; i < 4; ++i) { const int e = tid + 512 * i, row = e >> 5, c = e & 31; P.vst[i] = *(const u32x4*)(gv + (size_t)(row0 + row) * 512 + hp * 256 + c * 8); }
}
DI void gla_consts(unsigned char* ws, int hp, int tid, float (&wv)[8], float& gbias) {
    const int wave = tid >> 6, lane = tid & 63, r = lane & 31, h = lane >> 5;
    const int hl_ = wave >> 2, dir_ = (wave >> 1) & 1, db_ = wave & 1, ch_ = (hp * 2 + hl_) * 64 + 32 * db_ + r;
    const float* sm = (const float*)(ws + OFF_SMALL); const float* wsrc = sm + (dir_ ? SM_WDB : SM_WDF) + ch_;
#pragma unroll
    for (int j = 0; j < 8; ++j) wv[j] = wsrc[(8 * h + j) * 256];
    gbias = sm[(dir_ ? SM_BDB : SM_BDF) + ch_];
}
template <int PASS> DI void gla_unit(unsigned char* ws, bf16_t* U, LAS unsigned char* lds, int unit, int tid, GlaPre& P, int next_unit, const float (&wv)[8], const float gbias) {
    asm volatile("" : "+v"(tid));
    const int wave = tid >> 6, lane = tid & 63, r = lane & 31, h = lane >> 5, q4 = (lane & 15) >> 2, p4 = lane & 3, blk = (lane >> 4) & 1;
    const int gc = unit >> 1, hp = unit & 1, row0 = gc * 64;
    const bf16_t* sg = (const bf16_t*)(ws + OFF_SG);
    float* decay = (float*)(ws + OFF_DECAY); bf16_t* mix = (bf16_t*)(ws + OFF_MIX);
    unsigned short kraw[16], qraw[16];
#pragma unroll
    for (int t = 0; t < 16; ++t) { kraw[t] = P.kq[t].x; qraw[t] = P.kq[t].y; }
    { const int row = tid >> 3, c = tid & 7; *(LAS f32x4*)(lds + GL_RF + row * 128 + c * 16) = P.rf; }
#pragma unroll
    for (int i = 0; i < 4; ++i) { const int e = tid + 512 * i, row = e >> 5, c = e & 31; *(LAS u32x4*)(lds + GL_VIM + row * VIM_ST + c * 16) = P.vst[i]; }
    __syncthreads();
    {
        const int hl = wave >> 2, dir = (wave >> 1) & 1, db = wave & 1; const float bias = gbias;
        float wl[8];
#pragma unroll
        for (int j = 0; j < 8; ++j) { const float hi = __uint_as_float(pk2(wv[j], 0.f) << 16); wl[j] = wv[j] - hi; }
        const bf16x8 bhi = pack8(wv[0], wv[1], wv[2], wv[3], wv[4], wv[5], wv[6], wv[7]), blo = pack8(wl[0], wl[1], wl[2], wl[3], wl[4], wl[5], wl[6], wl[7]);
        LAS float* Z = (LAS float*)(lds + GL_EIM);
#pragma unroll
        for (int tb = 0; tb < 2; ++tb) {
            const LAS f32x4* rp = (const LAS f32x4*)(lds + GL_RF + (32 * tb + r) * 128 + (dir * 16 + 8 * h) * 4);
            const f32x4 a0 = rp[0], a1 = rp[1];
            const float av[8] = {a0.x, a0.y, a0.z, a0.w, a1.x, a1.y, a1.z, a1.w};
            float al[8];
#pragma unroll
            for (int j = 0; j < 8; ++j) { const float hi = __uint_as_float(pk2(av[j], 0.f) << 16); al[j] = av[j] - hi; }
            const bf16x8 ahi = pack8(av[0], av[1], av[2], av[3], av[4], av[5], av[6], av[7]), alo = pack8(al[0], al[1], al[2], al[3], al[4], al[5], al[6], al[7]);
            f32x16 z;
#pragma unroll
            for (int i = 0; i < 16; ++i) z[i] = bias;
            z = MFMA32(ahi, bhi, z); z = MFMA32(alo, bhi, z); z = MFMA32(ahi, blo, z);
#pragma unroll
            for (int i = 0; i < 16; ++i) Z[((hl * 2 + dir) * 64 + 32 * tb + crow(i, h)) * 64 + 32 * db + r] = logsig2(z[i]) * 0.0625f;
        }
    }
    __syncthreads();
    if (PASS != 3) {
        const int hl = wave >> 2, seg = wave & 3, head = hp * 2 + hl, d = lane, ch = head * 64 + d;
        float laf[16], lab[16], sf = 0.f, sb = 0.f;
        {   const LAS float* Z = (const LAS float*)(lds + GL_EIM);
#pragma unroll
            for (int t = 0; t < 16; ++t) { laf[t] = Z[((hl * 2 + 0) * 64 + seg * 16 + t) * 64 + d]; lab[t] = Z[((hl * 2 + 1) * 64 + seg * 16 + t) * 64 + d]; sf += laf[t]; sb += lab[t]; }
        }
        LAS float* tot = (LAS float*)(lds + GL_TOT);
        tot[((hl * 2 + 0) * 4 + seg) * 64 + d] = sf; tot[((hl * 2 + 1) * 4 + seg) * 64 + d] = sb;
        __syncthreads();
        float pref_f = 0.f, suff_f = 0.f, pref_b = 0.f, suff_b = 0.f;
#pragma unroll
        for (int s = 0; s < 4; ++s) { const float a = tot[((hl * 2 + 0) * 4 + s) * 64 + d], b = tot[((hl * 2 + 1) * 4 + s) * 64 + d];
            if (s < seg) { pref_f += a; pref_b += b; } else if (s > seg) { suff_f += a; suff_b += b; } }
        float kv[16];
#pragma unroll
        for (int t = 0; t < 16; ++t) kv[t] = bf2f(kraw[t]);
        LAS unsigned char* eim = lds + GL_EIM + (hl * 4 * 64 + d) * EIM_ST + seg * 32;
        if (PASS == 0) {
            float o[16]; float run = suff_f;
#pragma unroll
            for (int t = 15; t >= 0; --t) { o[t] = kv[t] * __builtin_amdgcn_exp2f(run); run += laf[t]; }
            *(LAS u32x4*)(eim) = (u32x4){pk2(o[0], o[1]), pk2(o[2], o[3]), pk2(o[4], o[5]), pk2(o[6], o[7])};
            *(LAS u32x4*)(eim + 16) = (u32x4){pk2(o[8], o[9]), pk2(o[10], o[11]), pk2(o[12], o[13]), pk2(o[14], o[15])};
            run = pref_b;
#pragma unroll
            for (int t = 0; t < 16; ++t) { o[t] = kv[t] * __builtin_amdgcn_exp2f(run); run += lab[t]; }
            *(LAS u32x4*)(eim + 64 * EIM_ST) = (u32x4){pk2(o[0], o[1]), pk2(o[2], o[3]), pk2(o[4], o[5]), pk2(o[6], o[7])};
            *(LAS u32x4*)(eim + 64 * EIM_ST + 16) = (u32x4){pk2(o[8], o[9]), pk2(o[10], o[11]), pk2(o[12], o[13]), pk2(o[14], o[15])};
            if (seg == 0) { decay[(size_t)((gc * 4 + head) * 2 + 0) * 64 + d] = __builtin_amdgcn_exp2f(sf + suff_f); decay[(size_t)((gc * 4 + head) * 2 + 1) * 64 + d] = __builtin_amdgcn_exp2f(sb + suff_b); }
        } else {
            float qv[16];
#pragma unroll
            for (int t = 0; t < 16; ++t) qv[t] = bf2f(qraw[t]);
            float oq[16], ok[16]; float run = pref_f;
#pragma unroll
            for (int t = 0; t < 16; ++t) { run += laf[t]; oq[t] = qv[t] * __builtin_amdgcn_exp2f(run); ok[t] = kv[t] * __builtin_amdgcn_exp2f(-run); }
            *(LAS u32x4*)(eim) = (u32x4){pk2(oq[0], oq[1]), pk2(oq[2], oq[3]), pk2(oq[4], oq[5]), pk2(oq[6], oq[7])};
            *(LAS u32x4*)(eim + 16) = (u32x4){pk2(oq[8], oq[9]), pk2(oq[10], oq[11]), pk2(oq[12], oq[13]), pk2(oq[14], oq[15])};
            *(LAS u32x4*)(eim + 64 * EIM_ST) = (u32x4){pk2(ok[0], ok[1]), pk2(ok[2], ok[3]), pk2(ok[4], ok[5]), pk2(ok[6], ok[7])};
            *(LAS u32x4*)(eim + 64 * EIM_ST + 16) = (u32x4){pk2(ok[8], ok[9]), pk2(ok[10], ok[11]), pk2(ok[12], ok[13]), pk2(ok[14], ok[15])};
            run = suff_b;
#pragma unroll
            for (int t = 15; t >= 0; --t) { run += lab[t]; oq[t] = qv[t] * __builtin_amdgcn_exp2f(run); ok[t] = kv[t] * __builtin_amdgcn_exp2f(-run); }
            *(LAS u32x4*)(eim + 128 * EIM_ST) = (u32x4){pk2(oq[0], oq[1]), pk2(oq[2], oq[3]), pk2(oq[4], oq[5]), pk2(oq[6], oq[7])};
            *(LAS u32x4*)(eim + 128 * EIM_ST + 16) = (u32x4){pk2(oq[8], oq[9]), pk2(oq[10], oq[11]), pk2(oq[12], oq[13]), pk2(oq[14], oq[15])};
            *(LAS u32x4*)(eim + 192 * EIM_ST) = (u32x4){pk2(ok[0], ok[1]), pk2(ok[2], ok[3]), pk2(ok[4], ok[5]), pk2(ok[6], ok[7])};
            *(LAS u32x4*)(eim + 192 * EIM_ST + 16) = (u32x4){pk2(ok[8], ok[9]), pk2(ok[10], ok[11]), pk2(ok[12], ok[13]), pk2(ok[14], ok[15])};
        }
    }
    __syncthreads();
    if (next_unit >= 0) gla_load<PASS>(P, ws, next_unit, tid);
    if (PASS == 0) {
        const int hl = wave >> 2, dblk = (wave >> 1) & 1, dvh = wave & 1, head = hp * 2 + hl;
#pragma unroll
        for (int dir = 0; dir < 2; ++dir) {
            f32x16 acc[2];
#pragma unroll
            for (int a = 0; a < 2; ++a)
#pragma unroll
                for (int i = 0; i < 16; ++i) acc[a][i] = 0.f;
#pragma unroll
            for (int s = 0; s < 4; ++s) {
                const bf16x8 af = *(const LAS bf16x8*)(lds + GL_EIM + ((hl * 4 + dir) * 64 + 32 * dblk + r) * EIM_ST + (16 * s + 8 * h) * 2);
#pragma unroll
                for (int dv2 = 0; dv2 < 2; ++dv2) { const int dvblk = 2 * dvh + dv2;
                    LAS unsigned char* a = lds + GL_VIM + (16 * s + 8 * h + q4) * VIM_ST + (hl * 128 + 32 * dvblk + 16 * blk + 4 * p4) * 2;
                    acc[dv2] = MFMA32(af, cat8(trr(a), trr(a + 4 * VIM_ST)), acc[dv2]); }
            }
            bf16_t* up = U + (size_t)((gc * 4 + head) * 2 + dir) * 8192;
#pragma unroll
            for (int dv2 = 0; dv2 < 2; ++dv2)
#pragma unroll
                for (int s2 = 0; s2 < 2; ++s2) { const int dvblk = 2 * dvh + dv2;
                    *(bf16x8*)(up + (((dblk * 4 + dvblk) * 2 + s2) * 64 + lane) * 8) =
                        pack8(acc[dv2][8 * s2], acc[dv2][8 * s2 + 1], acc[dv2][8 * s2 + 2], acc[dv2][8 * s2 + 3], acc[dv2][8 * s2 + 4], acc[dv2][8 * s2 + 5], acc[dv2][8 * s2 + 6], acc[dv2][8 * s2 + 7]); }
        }
    } else {
        const int hl = wave >> 2, ib = (wave >> 1) & 1, dvh = wave & 1, head = hp * 2 + hl;
        const int row = row0 + 32 * ib + r;
        u32x2 sgv[2][4];
#pragma unroll
        for (int dv2 = 0; dv2 < 2; ++dv2)
#pragma unroll
            for (int g4 = 0; g4 < 4; ++g4) sgv[dv2][g4] = *(const u32x2*)(sg + (size_t)row * 512 + head * 128 + 32 * (2 * dvh + dv2) + 8 * g4 + 4 * h);
        f32x16 y[2];
#pragma unroll
        for (int a2 = 0; a2 < 2; ++a2)
#pragma unroll
            for (int i = 0; i < 16; ++i) y[a2][i] = 0.f;
#pragma unroll
        for (int dir = 0; dir < 2; ++dir) {
            LAS unsigned char* QE = lds + GL_EIM + ((hl * 4 + 2 * dir) * 64) * EIM_ST; LAS unsigned char* KE = QE + 64 * EIM_ST;
            bf16x8 sfr[4][2]; bf16x8 qfr[4];
            { const bf16_t* sp = U + (size_t)((gc * 4 + head) * 2 + dir) * 8192;
#pragma unroll
                for (int sx = 0; sx < 4; ++sx)
#pragma unroll
                    for (int dv2 = 0; dv2 < 2; ++dv2) sfr[sx][dv2] = *(const bf16x8*)(sp + ((((sx >> 1) * 4 + 2 * dvh + dv2) * 2 + (sx & 1)) * 64 + lane) * 8); }
#pragma unroll
            for (int sx = 0; sx < 4; ++sx) { LAS unsigned char* a2 = QE + (16 * sx + 4 * h + q4) * EIM_ST + (32 * ib + 16 * blk + 4 * p4) * 2; qfr[sx] = cat8(trr(a2), trr(a2 + 8 * EIM_ST)); }
#pragma unroll
            for (int jb = 0; jb < 2; ++jb) {
                const bool need = dir == 0 ? (jb <= ib) : (jb >= ib);
                if (need) {
                    f32x16 x;
#pragma unroll
                    for (int i = 0; i < 16; ++i) x[i] = 0.f;
#pragma unroll
                    for (int sx = 0; sx < 4; ++sx) { LAS unsigned char* a2 = KE + (16 * sx + 4 * h + q4) * EIM_ST + (32 * jb + 16 * blk + 4 * p4) * 2; x = MFMA32(cat8(trr(a2), trr(a2 + 8 * EIM_ST)), qfr[sx], x); }
                    if (jb == ib) {
#pragma unroll
                        for (int i = 0; i < 16; ++i) { const int jj = crow(i, h); const bool keep = dir == 0 ? (jj <= r) : (jj > r); x[i] = keep ? x[i] : 0.f; }
                    }
                    const bf16x8 pk0 = pack8(x[0], x[1], x[2], x[3], x[4], x[5], x[6], x[7]), pk1 = pack8(x[8], x[9], x[10], x[11], x[12], x[13], x[14], x[15]);
#pragma unroll
                    for (int dv2 = 0; dv2 < 2; ++dv2) {
                        LAS unsigned char* a2 = lds + GL_VIM + (32 * jb + 4 * h + q4) * VIM_ST + (hl * 128 + 32 * (2 * dvh + dv2) + 16 * blk + 4 * p4) * 2;
                        y[dv2] = MFMA32(cat8(trr(a2), trr(a2 + 8 * VIM_ST)), pk0, y[dv2]);
                        y[dv2] = MFMA32(cat8(trr(a2 + 16 * VIM_ST), trr(a2 + 24 * VIM_ST)), pk1, y[dv2]); }
                }
            }
#pragma unroll
            for (int sx = 0; sx < 4; ++sx)
#pragma unroll
                for (int dv2 = 0; dv2 < 2; ++dv2) y[dv2] = MFMA32(sfr[sx][dv2], qfr[sx], y[dv2]);
        }
        float ssum = 0.f;
#pragma unroll
        for (int a2 = 0; a2 < 2; ++a2)
#pragma unroll
            for (int i = 0; i < 16; ++i) ssum += y[a2][i] * y[a2][i];
        ssum = xh_sum(ssum);
        LAS float* part = (LAS float*)(lds + GL_TOT);
        if (h == 0) part[wave * 32 + r] = ssum;
        __syncthreads();
        ssum += part[(wave ^ 1) * 32 + r];
        const float rstd = rsqrtf(ssum * (1.0f / 128.0f) + EPS);
#pragma unroll
        for (int dv2 = 0; dv2 < 2; ++dv2)
#pragma unroll
            for (int g2 = 0; g2 < 2; ++g2) {
                u32x2 w[2];
#pragma unroll
                for (int q = 0; q < 2; ++q) { const int g4 = 2 * g2 + q, dv = 32 * (2 * dvh + dv2) + 8 * g4 + 4 * h;
                    const f32x4 gn = *(const f32x4*)((const float*)(ws + OFF_SMALL) + SM_GN + dv);
                    const u32x2 sv = sgv[dv2][g4];
                    const float o0 = y[dv2][4 * g4] * rstd * gn.x * bflo(sv.x), o1 = y[dv2][4 * g4 + 1] * rstd * gn.y * bfhi(sv.x);
                    const float o2 = y[dv2][4 * g4 + 2] * rstd * gn.z * bflo(sv.y), o3 = y[dv2][4 * g4 + 3] * rstd * gn.w * bfhi(sv.y);
                    w[q] = (u32x2){pk2(o0, o1), pk2(o2, o3)}; }
                *(u32x4*)(mix + (size_t)row * DM + 512 + head * 128 + 32 * (2 * dvh + dv2) + 16 * g2 + 8 * h) = widen_pair(w[0], w[1]); }
    }
    __syncthreads();
}
DI void gla_scan(unsigned char* ws, bf16_t* U, int gtid) {
    if (gtid >= 96 * 1024) return;
    const int chain = gtid >> 10, e = gtid & 1023, lane = e & 63, fi = e >> 6, s2 = fi & 1, dblk = fi >> 3, h = lane >> 5;
    const int sq = chain >> 3, head = (chain >> 1) & 3, dir = chain & 1;
    const int g0 = sq < 8 ? 32 * sq : 256 + 128 * (sq - 8), n = sq < 8 ? 32 : 128;
    const int dbase = 32 * dblk + 16 * s2 + 4 * h;
    const float* decay = (const float*)(ws + OFF_DECAY);
    float S[8];
#pragma unroll
    for (int j = 0; j < 8; ++j) S[j] = 0.f;
    for (int c0 = 0; c0 < n; c0 += 16) {
        u32x4 uv[16]; f32x4 dl[16], dh[16];
#pragma unroll
        for (int i = 0; i < 16; ++i) { const int gc = dir ? g0 + n - 1 - (c0 + i) : g0 + c0 + i; const size_t it = (size_t)((gc * 4 + head) * 2 + dir);
            uv[i] = *(const u32x4*)(U + it * 8192 + e * 8); dl[i] = *(const f32x4*)(decay + it * 64 + dbase); dh[i] = *(const f32x4*)(decay + it * 64 + dbase + 8); }
#pragma unroll
        for (int i = 0; i < 16; ++i) { const int gc = dir ? g0 + n - 1 - (c0 + i) : g0 + c0 + i; const size_t it = (size_t)((gc * 4 + head) * 2 + dir);
            *(u32x4*)(U + it * 8192 + e * 8) = (u32x4){pk2(S[0], S[1]), pk2(S[2], S[3]), pk2(S[4], S[5]), pk2(S[6], S[7])};
            S[0] = dl[i].x * S[0] + bflo(uv[i].x); S[1] = dl[i].y * S[1] + bfhi(uv[i].x); S[2] = dl[i].z * S[2] + bflo(uv[i].y); S[3] = dl[i].w * S[3] + bfhi(uv[i].y);
            S[4] = dh[i].x * S[4] + bflo(uv[i].z); S[5] = dh[i].y * S[5] + bfhi(uv[i].z); S[6] = dh[i].z * S[6] + bflo(uv[i].w); S[7] = dh[i].w * S[7] + bfhi(uv[i].w); }
    }
}
DI void rgate_panel(unsigned char* ws, LAS unsigned char* lds, int pm, int tid) {
    const int wid = tid >> 6, lane = tid & 63, r = lane & 31, h = lane >> 5, rowb = pm * 256 + wid * 32;
    LAS float* sc = (LAS float*)lds + wid * 32;
    if (h == 0) sc[r] = rsqrtf(row_ss((const float*)(ws + OFF_SS + SS_BYTES), rowb + r) * (1.0f / DM) + EPS);
    const bf16_t* xa = (const bf16_t*)(ws + OFF_XB) + (size_t)(rowb + r) * DM + 8 * h;
    const bf16_t* wf = (const bf16_t*)(ws + OFF_WRF) + lane * 8;
    f32x16 z;
#pragma unroll
    for (int i = 0; i < 16; ++i) z[i] = 0.f;
#pragma unroll 16
    for (int sx = 0; sx < 64; ++sx) z = MFMA32(*(const bf16x8*)(xa + 16 * sx), *(const bf16x8*)(wf + sx * 512), z);
    lds_wait();
    float* rr = (float*)(ws + OFF_RR) + (size_t)rowb * 32 + r;
#pragma unroll
    for (int i = 0; i < 16; ++i) { const int row = crow(i, h); rr[row * 32] = z[i] * sc[row]; }
    lds_wait();
}
__global__ void __launch_bounds__(512, 2) hymba_fwd(Params p) {
    extern __shared__ __attribute__((aligned(16))) unsigned char shm[];
    LAS unsigned char* lds = (LAS unsigned char*)shm;
    cg::grid_group grid = cg::this_grid();
#define FRESH_WS() unsigned char* ws = opq_p(p.ws); int tid = threadIdx.x; asm volatile("" : "+v"(tid)); const int bid = opq_i(blockIdx.x), G = opq_i(gridDim.x)
#define GBAR(k) do { unsigned* _c = (unsigned*)(opq_p(p.ws) + OFF_BAR); xcd_barrier(_c, (volatile LAS unsigned*)(lds + XB_LDS_OFF)); } while (0)
    if (threadIdx.x < 4) ((volatile LAS unsigned*)(lds + XB_LDS_OFF))[threadIdx.x] = 0u;
    { FRESH_WS(); p0_prologue(p, lds, tid, G, bid); }
    grid.sync();
    if (threadIdx.x == 0) (void)xb_add(&((unsigned*)(opq_p(p.ws) + OFF_BAR))[XB_XCNT(xb_xcc_id())], 1u);
    {
        FRESH_WS();
        pg8::Gemm g{(const bf16_t*)(ws + OFF_XB), (const bf16_t*)(ws + OFF_WGU1), M_TOK, NGU, DM};
        EpiSwiglu E{(bf16_t*)(ws + OFF_BIG), (LAS float*)(lds + RSTD_OFF)};
        pg8::StaticOrder S; S.init(M_TOK, NGU, G, bid);
        rstd_prepass((LAS float*)(lds + RSTD_OFF), (const float*)(ws + OFF_SS), S, tid);
        pg8::gemm_phase(lds, g, S, E, tid);
        if (bid >= (G >> 1)) { const int nb = G - (G >> 1); p0_weights(p, lds, tid, (bid - (G >> 1)) * 8 + (tid >> 6), nb * 8, 2816, 10112); }
    }
    GBAR(1);
    {
        FRESH_WS();
        pg8::Gemm g{(const bf16_t*)(ws + OFF_BIG), (const bf16_t*)(ws + OFF_WD1), M_TOK, DM, FF};
        EpiResid E{(bf16_t*)(ws + OFF_XB), (float*)(ws + OFF_SS + 1 * SS_BYTES), 0.5f};
        pg8::StaticOrder S; S.init(M_TOK, DM, G, bid);
        pg8::gemm_phase(lds, g, S, E, tid);
    }
    GBAR(2);
    {
        FRESH_WS();
        pg8::Gemm g{(const bf16_t*)(ws + OFF_XB), (const bf16_t*)(ws + OFF_WIN), M_TOK, NIN, DM};
        EpiInProj E{ws, (LAS float*)(lds + RSTD_OFF)};
        pg8::StaticOrder S; S.init(M_TOK, NIN, G, bid);
        rstd_prepass((LAS float*)(lds + RSTD_OFF), (const float*)(ws + OFF_SS + 1 * SS_BYTES), S, tid);
        pg8::gemm_phase(lds, g, S, E, tid);
        {
            const int nfull = ((M_TOK / 256) * (NIN / 256)) % G, nb = nfull ? G - nfull : G, b0 = nfull ? nfull : 0;
            if (bid >= b0) for (int pm = bid - b0; pm < M_TOK / 256; pm += nb) rgate_panel(ws, lds, pm, tid);
        }
    }
    GBAR(3);
    {
        FRESH_WS();
        for (int u = bid; u < 768; u += G) attn_unit(ws, lds, u, tid);
        {   GlaPre P; float wv[8], gb; gla_consts(ws, bid & 1, tid, wv, gb); bf16_t* U = (bf16_t*)opq_p(p.out);
            if (bid < 1536) gla_load<0>(P, ws, bid, tid);
            for (int u = bid; u < 1536; u += G) gla_unit<0>(ws, U, lds, u, tid, P, (u + G < 1536) ? u + G : -1, wv, gb); }
    }
    GBAR(4);
    { FRESH_WS(); gla_scan(ws, (bf16_t*)opq_p(p.out), bid * 512 + tid); }
    GBAR(5);
    {
        FRESH_WS();
        {   GlaPre P; float wv[8], gb; gla_consts(ws, bid & 1, tid, wv, gb); bf16_t* U = (bf16_t*)opq_p(p.out);
            if (bid < 1536) gla_load<1>(P, ws, bid, tid);
            for (int u = bid; u < 1536; u += G) gla_unit<1>(ws, U, lds, u, tid, P, (u + G < 1536) ? u + G : -1, wv, gb); }
    }
    GBAR(6);
    {
        FRESH_WS();
        pg8::Gemm g{(const bf16_t*)(ws + OFF_MIX), (const bf16_t*)(ws + OFF_WOUT), M_TOK, DM, DM};
        EpiResid E{(bf16_t*)(ws + OFF_XB), (float*)(ws + OFF_SS + 2 * SS_BYTES), 1.0f};
        pg8::StaticOrder S; S.init(M_TOK, DM, G, bid);
        pg8::gemm_phase(lds, g, S, E, tid);
    }
    GBAR(7);
    {
        FRESH_WS();
        pg8::Gemm g{(const bf16_t*)(ws + OFF_XB), (const bf16_t*)(ws + OFF_WGU2), M_TOK, NGU, DM};
        EpiSwiglu E{(bf16_t*)(ws + OFF_BIG), (LAS float*)(lds + RSTD_OFF)};
        pg8::StaticOrder S; S.init(M_TOK, NGU, G, bid);
        rstd_prepass((LAS float*)(lds + RSTD_OFF), (const float*)(ws + OFF_SS + 2 * SS_BYTES), S, tid);
        pg8::gemm_phase(lds, g, S, E, tid);
    }
    GBAR(8);
    {
        FRESH_WS();
        pg8::Gemm g{(const bf16_t*)(ws + OFF_BIG), (const bf16_t*)(ws + OFF_WD2), M_TOK, DM, FF};
        EpiFinal E{p.out, (const bf16_t*)(ws + OFF_XB), (float*)(ws + OFF_SS + 3 * SS_BYTES), (const float*)(ws + OFF_SMALL) + SM_NF};
        pg8::StaticOrder S; S.init(M_TOK, DM, G, bid);
        pg8::gemm_phase(lds, g, S, E, tid);
    }
}

extern "C" void kernel_launch(void* const* d_in, const int* in_sizes, int n_in, void* d_out, int out_size, void* d_ws, size_t ws_size, hipStream_t stream) {
    static int grid_blocks = 0;
    if (!grid_blocks) {
        int dev = 0, cus = 0, per_cu = 0;
        hipGetDevice(&dev);
        hipDeviceGetAttribute(&cus, hipDeviceAttributeMultiprocessorCount, dev);
        hipFuncSetAttribute((const void*)hymba_fwd, hipFuncAttributeMaxDynamicSharedMemorySize, LDS_BYTES);
        hipOccupancyMaxActiveBlocksPerMultiprocessor(&per_cu, (const void*)hymba_fwd, 512, LDS_BYTES);
        if (per_cu < 1) { fprintf(stderr, "occupancy query returned %d\n", per_cu); per_cu = 1; }
        grid_blocks = cus * per_cu;
        if (grid_blocks > 256) grid_blocks = 256;
    }
    Params p{};
    for (int i = 0; i < 20; ++i) p.in[i] = (const float*)d_in[i];
    p.out = (float*)d_out; p.ws = (unsigned char*)d_ws;
    void* args[] = {&p};
    hipError_t e = hipLaunchCooperativeKernel((const void*)hymba_fwd, dim3(grid_blocks), dim3(512), args, LDS_BYTES, stream);
    if (e != hipSuccess) fprintf(stderr, "cooperative launch failed: %s (grid %d)\n", hipGetErrorString(e), grid_blocks);
}
```

```cpp
#include <hip/hip_runtime.h>
#include <hip/hip_cooperative_groups.h>
#include <cstdio>
namespace cg = cooperative_groups;

#define LAS __attribute__((address_space(3)))
typedef unsigned short bf16_t;
typedef short bf16x8 __attribute__((ext_vector_type(8)));
typedef short s16x4 __attribute__((ext_vector_type(4)));
typedef float f32x4 __attribute__((ext_vector_type(4)));
typedef float f32x2 __attribute__((ext_vector_type(2)));
typedef float f32x16 __attribute__((ext_vector_type(16)));
typedef unsigned u32x4 __attribute__((ext_vector_type(4)));
typedef unsigned u32x2 __attribute__((ext_vector_type(2)));
typedef __bf16 bf2_t __attribute__((ext_vector_type(2)));
#define DI __device__ __forceinline__

constexpr int M_TOK = 49152, MP = 16384, DM = 1024, FF = 2816, NGU = 5632, NIN = 2304, NINL = 2336;
constexpr float EPS = 1e-6f, LOG2E = 1.4426950408889634f;
constexpr size_t MiB = 1048576;
constexpr size_t OFF_WGU1 = 0, OFF_WD1 = 11534336, OFF_WIN = 17301504, OFF_WOUT = 22544384, OFF_WGU2 = 24641536, OFF_WD2 = 36175872;
constexpr size_t OFF_ROPE = 40 * MiB, OFF_SS = 42 * MiB, SS_BYTES = 3 * MiB, OFF_DECAY = 54 * MiB, OFF_XB = 56 * MiB, OFF_BIG = 152 * MiB;
constexpr size_t OFF_Q = OFF_BIG, OFF_K = OFF_BIG + 48 * MiB, OFF_V = OFF_BIG + 60 * MiB, OFF_GQ = OFF_BIG + 72 * MiB, OFF_GK = OFF_BIG + 96 * MiB,
                 OFF_GV = OFF_BIG + 120 * MiB, OFF_SG = OFF_BIG + 168 * MiB, OFF_RR = OFF_BIG + 216 * MiB, OFF_MIX = OFF_BIG + 222 * MiB;
constexpr size_t OFF_SMALL = OFF_DECAY + 1600 * 1024;
constexpr int SM_SINK = 0, SM_WDF = 64, SM_BDF = 4160, SM_WDB = 4416, SM_BDB = 8512, SM_GN = 8768, SM_NF = 8896, SM_TOTAL = 9920;
constexpr int RSTD_OFF = 131072, RSTD_MAXU = 18;
constexpr size_t OFF_WRF = OFF_WIN + (size_t)2304 * 2048;
constexpr int XB_LDS_OFF = RSTD_OFF + RSTD_MAXU * 1024;
constexpr int LDS_BYTES = XB_LDS_OFF + 16;

struct Params { const float* in[20]; float* out; unsigned char* ws; };

DI unsigned pk2(float a, float b) { f32x2 v = {a, b}; bf2_t r = __builtin_convertvector(v, bf2_t); return __builtin_bit_cast(unsigned, r); }
DI float bf2f(unsigned short b) { return __uint_as_float(((unsigned)b) << 16); }
DI float bflo(unsigned u) { return __uint_as_float(u << 16); }
DI float bfhi(unsigned u) { return __uint_as_float(u & 0xffff0000u); }
DI void lds_wait() { asm volatile("s_waitcnt lgkmcnt(0)" ::: "memory"); __builtin_amdgcn_wave_barrier(); }
#define MFMA32(a, b, c) __builtin_amdgcn_mfma_f32_32x32x16_bf16((a), (b), (c), 0, 0, 0)
DI float xh_max(float v) { const auto r = __builtin_amdgcn_permlane32_swap(__float_as_uint(v), __float_as_uint(v), false, false); return fmaxf(__uint_as_float(r[0]), __uint_as_float(r[1])); }
DI float xh_sum(float v) { const auto r = __builtin_amdgcn_permlane32_swap(__float_as_uint(v), __float_as_uint(v), false, false); return __uint_as_float(r[0]) + __uint_as_float(r[1]); }
DI u32x4 widen_pair(u32x2 a, u32x2 b) {
    const auto r0 = __builtin_amdgcn_permlane32_swap(a.x, b.x, false, false); const auto r1 = __builtin_amdgcn_permlane32_swap(a.y, b.y, false, false);
    return (u32x4){r0[0], r1[0], r0[1], r1[1]}; }
DI int crow(int reg, int h) { return (reg & 3) + 8 * (reg >> 2) + 4 * h; }
DI s16x4 trr(LAS unsigned char* p) { return __builtin_amdgcn_ds_read_tr16_b64_v4i16((LAS s16x4*)p); }
DI bf16x8 cat8(s16x4 lo, s16x4 hi) { return __builtin_shufflevector(lo, hi, 0, 1, 2, 3, 4, 5, 6, 7); }
DI bf16x8 pack8(float a0, float a1, float a2, float a3, float a4, float a5, float a6, float a7) {
    u32x4 p = {pk2(a0, a1), pk2(a2, a3), pk2(a4, a5), pk2(a6, a7)}; return __builtin_bit_cast(bf16x8, p); }
DI float silu_f(float g) { return g * __builtin_amdgcn_rcpf(1.0f + __expf(-g)); }
DI float row_ss(const float* ssb, int row) { const f32x4* q = (const f32x4*)(ssb + (size_t)row * 16); f32x4 a = q[0], b = q[1], c = q[2], d = q[3];
    return ((a.x + a.y) + (a.z + a.w)) + ((b.x + b.y) + (b.z + b.w)) + ((c.x + c.y) + (c.z + c.w)) + ((d.x + d.y) + (d.z + d.w)); }

DI int opq_i(int v) { asm volatile("" : "+v"(v)); return __builtin_amdgcn_readfirstlane(v); }
template <class T> DI T* opq_p(T* ptr) { unsigned lo = (unsigned)(unsigned long long)ptr, hi = (unsigned)((unsigned long long)ptr >> 32); asm volatile("" : "+v"(lo), "+v"(hi));
    lo = __builtin_amdgcn_readfirstlane(lo); hi = __builtin_amdgcn_readfirstlane(hi);
    typedef __attribute__((address_space(1))) T* gptr_t; return (T*)(gptr_t)(((unsigned long long)hi << 32) | lo); }
constexpr size_t OFF_BAR = OFF_DECAY + 1700 * 1024;
#define XB_TMO      128
#define XB_XCNT(j)  (256  + 64 * (j))
#define XB_XSUB(j)  (1280 + 64 * (j))
#define XB_XGEN(j)  (2304 + 64 * (j))
#define XB_TOP      3328
#define XB_TOPGEN   3392
#define XCD_BAR_WORDS 3456
#define XB_SPIN_CAP (1u << 20)
DI unsigned xb_ld(unsigned* p)              { return __hip_atomic_load(p, __ATOMIC_RELAXED, __HIP_MEMORY_SCOPE_AGENT); }
DI unsigned xb_add(unsigned* p, unsigned v) { return __hip_atomic_fetch_add(p, v, __ATOMIC_RELAXED, __HIP_MEMORY_SCOPE_AGENT); }
DI unsigned xb_xcc_id() { return (unsigned)__builtin_amdgcn_s_getreg((3 << 11) | 20) & 0xFu; }
#define XB_SPIN(cond, bar) do { unsigned _sp = 0; while (cond) { __builtin_amdgcn_s_sleep(1); \
    if ((++_sp & 255u) == 0u) { if (xb_ld(&(bar)[XB_TMO])) break; if (_sp > XB_SPIN_CAP) { atomicAdd(&(bar)[XB_TMO], 1u); break; } } } } while (0)
DI void xcd_barrier_complete(unsigned* bar, unsigned x, unsigned& nloc, unsigned& nx) {
    const unsigned G = gridDim.x * gridDim.y * gridDim.z;
    unsigned sum, cnt, mine, sp = 0u;
    for (;;) {
        sum = 0u; cnt = 0u; mine = 0u;
#pragma unroll
        for (unsigned j = 0; j < 16; ++j) { const unsigned c = xb_ld(&bar[XB_XCNT(j)]); sum += c; cnt += (c > 0u) ? 1u : 0u; mine = (j == x) ? c : mine; }
        if (sum == G) break;
        __builtin_amdgcn_s_sleep(1);
        if ((++sp & 255u) == 0u) { if (xb_ld(&bar[XB_TMO])) break; if (sp > XB_SPIN_CAP) { atomicAdd(&bar[XB_TMO], 1u); break; } }
    }
    nloc = mine > 0u ? mine : 1u; nx = cnt > 0u ? cnt : 1u;
}
DI void xcd_barrier(unsigned* bar, volatile LAS unsigned* st) {
    asm volatile("s_waitcnt vmcnt(0)" ::: "memory");
    __syncthreads();
    if (threadIdx.x == 0) {
        const unsigned x = xb_xcc_id();
        __builtin_amdgcn_s_waitcnt(0);
        unsigned nloc = st[0], nx = st[1];
        if (nloc == 0u) { xcd_barrier_complete(bar, x, nloc, nx); st[0] = nloc; st[1] = nx; }
        const unsigned old = xb_add(&bar[XB_XSUB(x)], 1u);
        const unsigned gen = old / nloc;
        if (old + 1u == (gen + 1u) * nloc) {
            __builtin_amdgcn_fence(__ATOMIC_RELEASE, "agent");
            asm volatile("s_waitcnt vmcnt(0)" ::: "memory");
            const unsigned og = xb_add(&bar[XB_TOP], 1u);
            const unsigned tg = og / nx;
            if (og + 1u == (tg + 1u) * nx) xb_add(&bar[XB_TOPGEN], 1u);
            else XB_SPIN(xb_ld(&bar[XB_TOPGEN]) == tg, bar);
            __builtin_amdgcn_fence(__ATOMIC_ACQUIRE, "agent");
            xb_add(&bar[XB_XGEN(x)], 1u);
            asm volatile("s_waitcnt vmcnt(0)" ::: "memory");
        } else {
            XB_SPIN(xb_ld(&bar[XB_XGEN(x)]) == gen, bar);
            __builtin_amdgcn_fence(__ATOMIC_ACQUIRE, "agent");
            asm volatile("s_waitcnt vmcnt(0)" ::: "memory");
        }
    }
    __syncthreads();
}

namespace pg8 {
#define PG8_LAS __attribute__((address_space(3)))
constexpr int BM = 256, BK = 64, HALF = 128, HTB = HALF * BK * 2, STAGE_BYTES = 8 * HTB, NXCD = 8, WGM = 8;
__host__ __device__ __forceinline__ int lds_byte(int r, int c) { const int st = (r >> 4) * 2 + (c >> 5), rr = r & 15, cc = c & 31, ob = rr * 64 + cc * 2; return st * 1024 + (ob ^ (((ob >> 9) & 1) << 5)); }
__host__ __device__ __forceinline__ void stage_rc(int b, int& R, int& C) { const int st = b / 1024, sb = b % 1024, swz = sb ^ (((sb >> 9) & 1) << 5); R = (st >> 1) * 16 + swz / 64; C = (st & 1) * 32 + (swz % 64) / 2; }
__host__ __device__ __forceinline__ int perm32(int rho) { const int n = rho >> 4, i = rho & 15; return 8 * (i >> 2) + 4 * n + (i & 3); }
struct Unit { int pm, pn; };
struct Gemm { const bf16_t* A; const bf16_t* Bt; int M, N, K; };
struct StaticOrder {
    int nM, nN, nwg, G, c;
    __host__ __device__ void init(int M, int N, int G_, int c_) { nM = M / BM; nN = N / BM; nwg = nM * nN; G = G_; c = c_; }
    __host__ __device__ bool next(int i, Unit& u) const {
        const long L = (long)i * G + c; if (L >= nwg) return false;
        int wgid = (int)L; { const int q = nwg / NXCD, r = nwg % NXCD, xcd = wgid % NXCD, off = wgid / NXCD; wgid = (xcd < r ? xcd * (q + 1) : r * (q + 1) + (xcd - r) * q) + off; }
        const int nig = WGM * nN, gid = wgid / nig, fm = gid * WGM, gsz = (nM - fm) < WGM ? (nM - fm) : WGM;
        u.pm = fm + ((wgid % nig) % gsz); u.pn = (wgid % nig) / gsz; return true;
    }
    __device__ __forceinline__ void a_ready(const Unit&) const {}
    __device__ __forceinline__ void done(const Unit&) const {}
};
template <class Epi, class Sched>
__device__ __forceinline__ void gemm_phase(PG8_LAS unsigned char* lds, const Gemm g, const Sched& S, const Epi& E, const int tid) {
    const int wid = __builtin_amdgcn_readfirstlane(tid >> 6), lane = tid & 63, wr = wid >> 2, wc = wid & 3, fr = lane & 15, fq = lane >> 4;
    const int K = g.K, nt = K / BK;
#define PG8_STAMP() do { } while (0)
    unsigned voffA[2], voffB[2];
#pragma unroll
    for (int i = 0; i < 2; ++i) { int R, C; stage_rc(tid * 16 + i * 8192, R, C); const int Rb = Epi::PERM ? ((R & ~31) + perm32(R & 31)) : R;
        voffA[i] = (unsigned)(R * K + C) * 2u; voffB[i] = (unsigned)(Rb * K + C) * 2u; }
    const size_t kstep = (size_t)(BK * 2);
    const size_t hstep = (size_t)HALF * K * 2;
    const size_t tstep = 2 * hstep;
    const unsigned ldsw = (unsigned)wid * 1024u;
    const int aoff = lds_byte(wr * 64 + fr, fq * 8), boff = lds_byte(wc * 32 + fr, fq * 8);
#define PG8_SA(b, h) (((b) * 2 + (h)) * HTB)
#define PG8_SB(b, h) ((4 + (b) * 2 + (h)) * HTB)
#define PG8_STAGE(bufoff, gbase, voff) do { _Pragma("unroll") for (int _i = 0; _i < 2; ++_i) \
        __builtin_amdgcn_global_load_lds((const unsigned*)((const char*)(gbase) + (voff)[_i]), (PG8_LAS unsigned*)(lds + (bufoff) + ldsw + _i * 8192), 16, 0, 0); } while (0)
#define PG8_LDA(dst, b, h) do { _Pragma("unroll") for (int m = 0; m < 4; ++m) _Pragma("unroll") for (int k = 0; k < 2; ++k) dst[m][k] = *(const PG8_LAS bf16x8*)(lds + PG8_SA(b, h) + aoff + m * 2048 + k * 1024); } while (0)
#define PG8_LDB(dst, b, h) do { _Pragma("unroll") for (int n = 0; n < 2; ++n) _Pragma("unroll") for (int k = 0; k < 2; ++k) dst[n][k] = *(const PG8_LAS bf16x8*)(lds + PG8_SB(b, h) + boff + n * 2048 + k * 1024); } while (0)
#define PG8_MMA(ai, bj, At, Bt) do { __builtin_amdgcn_s_setprio(1); _Pragma("unroll") for (int m = 0; m < 4; ++m) _Pragma("unroll") for (int n = 0; n < 2; ++n) _Pragma("unroll") for (int k = 0; k < 2; ++k) \
        acc[ai][bj][m][n] = __builtin_amdgcn_mfma_f32_16x16x32_bf16(Bt[n][k], At[m][k], acc[ai][bj][m][n], 0, 0, 0); __builtin_amdgcn_s_setprio(0); } while (0)
#define PG8_WAIT_V(n) asm volatile("s_waitcnt vmcnt(" #n ")" ::: "memory")
#define PG8_WAIT_L(n) asm volatile("s_waitcnt lgkmcnt(" #n ")" ::: "memory")
#define PG8_BAR __builtin_amdgcn_s_barrier()
#define PG8_SCHED __builtin_amdgcn_sched_barrier(0)
    Unit cur, nxt; int ui = 0;
    if (!S.next(0, cur)) return;
    f32x4 acc[2][2][4][2];
#pragma unroll
    for (int a = 0; a < 2; ++a)
#pragma unroll
        for (int b = 0; b < 2; ++b)
#pragma unroll
            for (int m = 0; m < 4; ++m)
#pragma unroll
                for (int n = 0; n < 2; ++n) acc[a][b][m][n] = (f32x4){0.f, 0.f, 0.f, 0.f};
    bf16x8 At[4][2], B0[2][2], B1[2][2];
    const char* cA = (const char*)g.A + (size_t)cur.pm * tstep; const char* cB = (const char*)g.Bt + (size_t)cur.pn * tstep;
    S.a_ready(cur);
    PG8_STAGE(PG8_SB(0, 0), cB, voffB); PG8_STAGE(PG8_SA(0, 0), cA, voffA); PG8_STAGE(PG8_SB(0, 1), cB + hstep, voffB); PG8_STAGE(PG8_SA(0, 1), cA + hstep, voffA);
    if (wr == 1) PG8_BAR;
    PG8_WAIT_V(4); PG8_BAR;
    PG8_STAGE(PG8_SB(1, 0), cB + kstep, voffB); PG8_STAGE(PG8_SA(1, 0), cA + kstep, voffA); PG8_STAGE(PG8_SB(1, 1), cB + hstep + kstep, voffB);
    PG8_WAIT_V(6); PG8_BAR;
    PG8_STAMP();
    for (;;) {
        const bool has_next = S.next(ui + 1, nxt);
        const char* nA = has_next ? (const char*)g.A + (size_t)nxt.pm * tstep : cA; const char* nB = has_next ? (const char*)g.Bt + (size_t)nxt.pn * tstep : cB;
        for (int t = 0; t < nt; t += 2) {
            const bool last = (t == nt - 2);
            const char* a1 = cA + (size_t)(t + 1) * kstep;
            const char* a2 = last ? nA : cA + (size_t)(t + 2) * kstep; const char* b2 = last ? nB : cB + (size_t)(t + 2) * kstep;
            const char* a3 = a2 + kstep; const char* b3 = b2 + kstep;
            if (last && has_next) S.a_ready(nxt);
            PG8_LDB(B0, 0, 0); PG8_SCHED; PG8_LDA(At, 0, 0); PG8_STAGE(PG8_SA(1, 1), a1 + hstep, voffA);
            PG8_WAIT_L(8); PG8_BAR; PG8_WAIT_L(0); PG8_MMA(0, 0, At, B0); PG8_BAR; PG8_SCHED;
            PG8_LDB(B1, 0, 1); PG8_STAGE(PG8_SB(0, 0), b2, voffB);
            PG8_BAR; PG8_WAIT_L(0); PG8_MMA(0, 1, At, B1); PG8_BAR;
            PG8_LDA(At, 0, 1); PG8_STAGE(PG8_SA(0, 0), a2, voffA);
            PG8_BAR; PG8_WAIT_L(0); PG8_MMA(1, 0, At, B0); PG8_BAR; PG8_SCHED;
            PG8_STAGE(PG8_SB(0, 1), b2 + hstep, voffB);
            PG8_WAIT_V(6); PG8_BAR; PG8_MMA(1, 1, At, B1); PG8_BAR;
            PG8_LDB(B0, 1, 0); PG8_SCHED; PG8_LDA(At, 1, 0); PG8_STAGE(PG8_SA(0, 1), a2 + hstep, voffA);
            PG8_WAIT_L(8); PG8_BAR; PG8_WAIT_L(0); PG8_MMA(0, 0, At, B0); PG8_BAR; PG8_SCHED;
            PG8_LDB(B1, 1, 1); PG8_STAGE(PG8_SB(1, 0), b3, voffB);
            PG8_BAR; PG8_WAIT_L(0); PG8_MMA(0, 1, At, B1); PG8_BAR;
            PG8_LDA(At, 1, 1); PG8_STAGE(PG8_SA(1, 0), a3, voffA);
            PG8_BAR; PG8_WAIT_L(0); PG8_MMA(1, 0, At, B0); PG8_BAR; PG8_SCHED;
            PG8_STAGE(PG8_SB(1, 1), b3 + hstep, voffB);
            PG8_WAIT_V(6); PG8_BAR; PG8_MMA(1, 1, At, B1); PG8_BAR;
        }
        PG8_STAMP();
        if constexpr (!Epi::AFTER_DRAIN) { E(acc, cur, wr, wc, fr, fq, ui); S.done(cur); }
        PG8_STAMP();
        if (!has_next) break;
#pragma unroll
        for (int a = 0; a < 2; ++a)
#pragma unroll
            for (int b = 0; b < 2; ++b)
#pragma unroll
                for (int m = 0; m < 4; ++m)
#pragma unroll
                    for (int n = 0; n < 2; ++n) acc[a][b][m][n] = (f32x4){0.f, 0.f, 0.f, 0.f};
        cur = nxt; cA = nA; cB = nB; ++ui;
    }
    PG8_WAIT_V(0);
    if (wr == 0) PG8_BAR;
    PG8_BAR;
#undef PG8_STAMP
#undef PG8_SA
#undef PG8_SB
#undef PG8_STAGE
#undef PG8_LDA
#undef PG8_LDB
#undef PG8_MMA
#undef PG8_WAIT_V
#undef PG8_WAIT_L
#undef PG8_BAR
#undef PG8_SCHED
}
}
using pg8::Unit;
DI void rstd_prepass(LAS float* tab, const float* ss, const pg8::StaticOrder& S, int tid) {
    const int w8 = __builtin_amdgcn_readfirstlane(tid >> 8), r = tid & 255;
    f32x4 a[9][4]; bool ok[9];
#pragma unroll
    for (int j = 0; j < 9; ++j) { Unit u; ok[j] = S.next(w8 + 2 * j, u);
        if (ok[j]) { const f32x4* q = (const f32x4*)(ss + (size_t)(u.pm * 256 + r) * 16); a[j][0] = q[0]; a[j][1] = q[1]; a[j][2] = q[2]; a[j][3] = q[3]; } }
#pragma unroll
    for (int j = 0; j < 9; ++j) if (ok[j]) {
        const float v = ((a[j][0].x + a[j][0].y) + (a[j][0].z + a[j][0].w)) + ((a[j][1].x + a[j][1].y) + (a[j][1].z + a[j][1].w)) + ((a[j][2].x + a[j][2].y) + (a[j][2].z + a[j][2].w)) + ((a[j][3].x + a[j][3].y) + (a[j][3].z + a[j][3].w));
        tab[(w8 + 2 * j) * 256 + r] = rsqrtf(v * (1.0f / DM) + EPS); }
    __syncthreads();
}

struct EpiSwiglu {
    static constexpr bool PERM = true, AFTER_DRAIN = false;
    bf16_t* act; LAS float* tab;
    DI void operator()(const f32x4 (&acc)[2][2][4][2], const Unit& u, int wr, int wc, int fr, int fq, int ui) const {
        const int row0 = u.pm * 256 + wr * 64 + fr, col0 = u.pn * 128 + wc * 32 + 8 * fq;
#pragma unroll
        for (int ai = 0; ai < 2; ++ai)
#pragma unroll
            for (int m = 0; m < 4; ++m) {
                const int row = row0 + ai * 128 + m * 16;
                const float rstd = tab[ui * 256 + wr * 64 + fr + ai * 128 + m * 16];
                float o[8];
#pragma unroll
                for (int n = 0; n < 2; ++n)
#pragma unroll
                    for (int j = 0; j < 4; ++j) { const float gv = acc[ai][0][m][n][j] * rstd, uv = acc[ai][1][m][n][j] * rstd; o[4 * n + j] = silu_f(gv) * uv; }
                u32x4 pk = {pk2(o[0], o[1]), pk2(o[2], o[3]), pk2(o[4], o[5]), pk2(o[6], o[7])};
                __builtin_nontemporal_store(pk, (u32x4*)(act + (size_t)row * FF + col0));
            }
    }
};
struct EpiResid {
    static constexpr bool PERM = true, AFTER_DRAIN = false;
    bf16_t* xb; float* ssout; float scale;
    DI void operator()(const f32x4 (&acc)[2][2][4][2], const Unit& u, int wr, int wc, int fr, int fq, int ui) const {
        const int row0 = u.pm * 256 + wr * 64 + fr, col0 = u.pn * 256 + wc * 32 + 8 * fq;
#pragma unroll
        for (int ai = 0; ai < 2; ++ai)
#pragma unroll
            for (int m = 0; m < 4; ++m) {
                const int row = row0 + ai * 128 + m * 16;
                bf16_t* xo = xb + (size_t)row * DM + col0;
                float sq = 0.f;
#pragma unroll
                for (int bj = 0; bj < 2; ++bj) {
                    const u32x4 o = *(const u32x4*)(xo + bj * 128);
                    const f32x4 o0 = {bflo(o.x), bfhi(o.x), bflo(o.y), bfhi(o.y)}, o1 = {bflo(o.z), bfhi(o.z), bflo(o.w), bfhi(o.w)};
                    const f32x4 v0 = o0 + acc[ai][bj][m][0] * scale, v1 = o1 + acc[ai][bj][m][1] * scale;
                    *(u32x4*)(xo + bj * 128) = (u32x4){pk2(v0.x, v0.y), pk2(v0.z, v0.w), pk2(v1.x, v1.y), pk2(v1.z, v1.w)};
                    sq += (v0.x * v0.x + v0.y * v0.y) + (v0.z * v0.z + v0.w * v0.w) + (v1.x * v1.x + v1.y * v1.y) + (v1.z * v1.z + v1.w * v1.w);
                }
                sq += __shfl_xor(sq, 16); sq += __shfl_xor(sq, 32);
                if (fq == 0) ssout[(size_t)row * 16 + u.pn * 4 + wc] = sq;
            }
    }
};
struct EpiFinal {
    static constexpr bool PERM = true, AFTER_DRAIN = false;
    float* xout; const bf16_t* xb; float* ss; const float* gain;
    DI void operator()(f32x4 (&acc)[2][2][4][2], const Unit& u, int wr, int wc, int fr, int fq, int ui) const {
        const int row0 = u.pm * 256 + wr * 64 + fr, col0 = u.pn * 256 + wc * 32 + 8 * fq;
#pragma unroll
        for (int ai = 0; ai < 2; ++ai)
#pragma unroll
            for (int m = 0; m < 4; ++m) {
                const int row = row0 + ai * 128 + m * 16;
                const bf16_t* xo = xb + (size_t)row * DM + col0;
                float sq = 0.f;
#pragma unroll
                for (int bj = 0; bj < 2; ++bj) {
                    const u32x4 o = *(const u32x4*)(xo + bj * 128);
                    const f32x4 o0 = {bflo(o.x), bfhi(o.x), bflo(o.y), bfhi(o.y)}, o1 = {bflo(o.z), bfhi(o.z), bflo(o.w), bfhi(o.w)};
                    const f32x4 v0 = o0 + acc[ai][bj][m][0] * 0.5f, v1 = o1 + acc[ai][bj][m][1] * 0.5f;
                    acc[ai][bj][m][0] = v0; acc[ai][bj][m][1] = v1;
                    sq += (v0.x * v0.x + v0.y * v0.y) + (v0.z * v0.z + v0.w * v0.w) + (v1.x * v1.x + v1.y * v1.y) + (v1.z * v1.z + v1.w * v1.w);
                }
                sq += __shfl_xor(sq, 16); sq += __shfl_xor(sq, 32);
                if (fq == 0) __hip_atomic_store(ss + (size_t)row * 16 + u.pn * 4 + wc, sq, __ATOMIC_RELAXED, __HIP_MEMORY_SCOPE_AGENT);
            }
        f32x4 g[2][2];
#pragma unroll
        for (int bj = 0; bj < 2; ++bj) { g[bj][0] = *(const f32x4*)(gain + col0 + bj * 128); g[bj][1] = *(const f32x4*)(gain + col0 + bj * 128 + 4); }
        unsigned spins = 0;
#pragma unroll
        for (int ai = 0; ai < 2; ++ai)
#pragma unroll
            for (int m = 0; m < 4; ++m) {
                const int row = row0 + ai * 128 + m * 16;
                float* sl = ss + (size_t)row * 16 + 4 * fq;
                float a, b, c, d;
                for (;;) {
                    a = __hip_atomic_load(sl, __ATOMIC_RELAXED, __HIP_MEMORY_SCOPE_AGENT); b = __hip_atomic_load(sl + 1, __ATOMIC_RELAXED, __HIP_MEMORY_SCOPE_AGENT);
                    c = __hip_atomic_load(sl + 2, __ATOMIC_RELAXED, __HIP_MEMORY_SCOPE_AGENT); d = __hip_atomic_load(sl + 3, __ATOMIC_RELAXED, __HIP_MEMORY_SCOPE_AGENT);
                    const bool nr = (a < 0.f) || (b < 0.f) || (c < 0.f) || (d < 0.f);
                    if (__builtin_amdgcn_ballot_w64(nr) == 0ull || ++spins > (1u << 20)) break;
                    __builtin_amdgcn_s_sleep(1);
                }
                float s = (a + b) + (c + d);
                s += __shfl_xor(s, 16); s += __shfl_xor(s, 32);
                const float rstd = rsqrtf(s * (1.0f / DM) + EPS);
                float* xo = xout + (size_t)row * DM + col0;
#pragma unroll
                for (int bj = 0; bj < 2; ++bj) { __builtin_nontemporal_store(acc[ai][bj][m][0] * rstd * g[bj][0], (f32x4*)(xo + bj * 128)); __builtin_nontemporal_store(acc[ai][bj][m][1] * rstd * g[bj][1], (f32x4*)(xo + bj * 128 + 4)); }
            }
    }
};
struct EpiInProj {
    static constexpr bool PERM = true, AFTER_DRAIN = false;
    unsigned char* ws; LAS float* tab;
    DI void operator()(const f32x4 (&acc)[2][2][4][2], const Unit& u, int wr, int wc, int fr, int fq, int ui) const {
        const int row0 = u.pm * 256 + wr * 64 + fr, t = u.pn;
        const LAS float* tb = tab + ui * 256 + wr * 64 + fr;
        if (t <= 2) {
            const float* cosT = (const float*)(ws + OFF_ROPE); const float* sinT = cosT + 8192 * 32;
            const bool rot = (t < 2) || (wc < 2);
            bf16_t* base; int ld;
            if (t < 2) { base = (bf16_t*)(ws + OFF_Q) + (t * 4 + wc) * 64; ld = 512; }
            else if (wc < 2) { base = (bf16_t*)(ws + OFF_K) + wc * 64; ld = 128; }
            else { base = (bf16_t*)(ws + OFF_V) + (wc - 2) * 64; ld = 128; }
#pragma unroll
            for (int ai = 0; ai < 2; ++ai)
#pragma unroll
                for (int m = 0; m < 4; ++m) {
                    const int row = row0 + ai * 128 + m * 16;
                    const float rstd = tb[ai * 128 + m * 16];
                    const int pos = row < MP ? (row & 2047) : (row & 8191);
                    const float sc = (t < 2) ? (0.125f * LOG2E) * rstd : rstd;
                    bf16_t* dst = base + (size_t)row * ld + 8 * fq;
#pragma unroll
                    for (int n = 0; n < 2; ++n) {
                        f32x4 cs = {1.f, 1.f, 1.f, 1.f}, sn = {0.f, 0.f, 0.f, 0.f};
                        if (rot) { cs = *(const f32x4*)(cosT + pos * 32 + 8 * fq + 4 * n); sn = *(const f32x4*)(sinT + pos * 32 + 8 * fq + 4 * n); }
                        const f32x4 x1 = acc[ai][0][m][n] * sc, x2 = acc[ai][1][m][n] * sc;
                        const f32x4 o1 = x1 * cs - x2 * sn, o2 = x2 * cs + x1 * sn;
                        *(u32x2*)(dst + 4 * n) = (u32x2){pk2(o1.x, o1.y), pk2(o1.z, o1.w)};
                        *(u32x2*)(dst + 32 + 4 * n) = (u32x2){pk2(o2.x, o2.y), pk2(o2.z, o2.w)};
                    }
                }
        } else if (t <= 8) {
            bf16_t* base; int ld; float sc = 1.0f;
            if (t == 3) { base = (bf16_t*)(ws + OFF_GQ); ld = 256; sc = 0.125f; }
            else if (t == 4) { base = (bf16_t*)(ws + OFF_GK); ld = 256; }
            else if (t <= 6) { base = (bf16_t*)(ws + OFF_GV) + (t - 5) * 256; ld = 512; }
            else { base = (bf16_t*)(ws + OFF_SG) + (t - 7) * 256; ld = 512; }
            const bool act = t >= 7;
#pragma unroll
            for (int ai = 0; ai < 2; ++ai)
#pragma unroll
                for (int m = 0; m < 4; ++m) {
                    const int row = row0 + ai * 128 + m * 16;
                    const float rstd = tb[ai * 128 + m * 16] * sc;
                    bf16_t* dst = base + (size_t)row * ld + wc * 32 + 8 * fq;
#pragma unroll
                    for (int bj = 0; bj < 2; ++bj) {
                        f32x4 v0 = acc[ai][bj][m][0] * rstd, v1 = acc[ai][bj][m][1] * rstd;
                        if (act) {
#pragma unroll
                            for (int j = 0; j < 4; ++j) { v0[j] = silu_f(v0[j]); v1[j] = silu_f(v1[j]); } }
                        *(u32x4*)(dst + bj * 128) = (u32x4){pk2(v0.x, v0.y), pk2(v0.z, v0.w), pk2(v1.x, v1.y), pk2(v1.z, v1.w)};
                    }
                }
        }
    }
};
DI void p0_item(const float* src, int ld, int col0, bool zero, const float* gain, bf16_t* dst, int K, int p0, int k0, LAS float* scr, int lane) {
    const int kr = lane >> 3, n4 = (lane & 7) * 4;
    f32x4 w[8];
#pragma unroll
    for (int i = 0; i < 8; ++i) w[i] = zero ? (f32x4){0.f, 0.f, 0.f, 0.f} : __builtin_nontemporal_load((const f32x4*)(src + (size_t)(k0 + 8 * i + kr) * ld + col0 + n4));
    if (gain) {
#pragma unroll
        for (int i = 0; i < 8; ++i) w[i] = w[i] * gain[k0 + 8 * i + kr]; }
#pragma unroll
    for (int i = 0; i < 8; ++i) { LAS float* d = scr + (8 * i + kr) * 33 + n4; d[0] = w[i].x; d[1] = w[i].y; d[2] = w[i].z; d[3] = w[i].w; }
    lds_wait();
    const int c = lane & 7;
#pragma unroll
    for (int j = 0; j < 4; ++j) { const int n = (lane >> 3) + 8 * j; const LAS float* s = scr + (8 * c) * 33 + n;
        u32x4 o = {pk2(s[0], s[33]), pk2(s[66], s[99]), pk2(s[132], s[165]), pk2(s[198], s[231])};
        *(u32x4*)(dst + (size_t)(p0 + n) * K + k0 + 8 * c) = o; }
    lds_wait();
}
DI void p0_weights(const Params& p, LAS unsigned char* lds, int tid, int gw, int NGW, int lo, int hi) {
    const int wave = tid >> 6, lane = tid & 63; unsigned char* ws = p.ws;
    LAS float* scr = (LAS float*)(lds + wave * 8448);
    for (int it = lo + gw; it < hi; it += NGW) {
        int r = it, mat;
        if (r < 2816) mat = 0; else if ((r -= 2816) < 1408) mat = 1; else if ((r -= 1408) < 1152) mat = 2; else if ((r -= 1152) < 512) mat = 3; else if ((r -= 512) < 2816) mat = 4; else { r -= 2816; mat = 5; }
        if (mat == 0 || mat == 4) {
            const int kb = r / 176, pg = r % 176, pp = pg * 32, pn = pp >> 8, bj = (pp >> 7) & 1, cc = pp & 127;
            const float* src = p.in[mat == 0 ? (bj ? 4 : 3) : (bj ? 17 : 16)];
            p0_item(src, FF, 128 * pn + cc, false, p.in[mat == 0 ? 2 : 15], (bf16_t*)(ws + (mat == 0 ? OFF_WGU1 : OFF_WGU2)), DM, pp, kb * 64, scr, lane);
        } else if (mat == 1 || mat == 5) {
            const int kb = r / 32, pg = r % 32;
            p0_item(p.in[mat == 1 ? 5 : 18], DM, pg * 32, false, nullptr, (bf16_t*)(ws + (mat == 1 ? OFF_WD1 : OFF_WD2)), FF, pg * 32, kb * 64, scr, lane);
        } else if (mat == 2) {
            const int kb = r / 72, pg = r % 72, pp = pg * 32, t = pp >> 8, qq = pp & 255;
            int col; const bool zero = false;
            if (t <= 2) col = 256 * t + 64 * ((qq & 127) >> 5) + 32 * (qq >> 7);
            else col = pp;
            p0_item(p.in[7], NINL, col, zero, p.in[6], (bf16_t*)(ws + OFF_WIN), DM, pp, kb * 64, scr, lane);
        } else {
            const int kb = r / 32, pg = r % 32;
            p0_item(p.in[14], DM, pg * 32, false, nullptr, (bf16_t*)(ws + OFF_WOUT), DM, pg * 32, kb * 64, scr, lane);
        }
    }
}
DI void p0_prologue(const Params& p, LAS unsigned char* lds, int tid, int G, int bid) {
    const int wave = tid >> 6, lane = tid & 63, gw = bid * 8 + wave, NGW = G * 8;
    unsigned char* ws = p.ws;
    p0_weights(p, lds, tid, gw, NGW, 0, 2816);
    bf16_t* xb = (bf16_t*)(ws + OFF_XB); float* ss0 = (float*)(ws + OFF_SS);
    for (int row0 = gw; row0 < M_TOK; row0 += 4 * NGW) {
        f32x4 v[4][4]; bool has[4];
#pragma unroll
        for (int q = 0; q < 4; ++q) { const int row = row0 + q * NGW; has[q] = row < M_TOK; const int rc = has[q] ? row : row0;
            const float* xr = rc < MP ? p.in[0] + (size_t)rc * DM : p.in[1] + (size_t)(rc - MP) * DM;
#pragma unroll
            for (int j = 0; j < 4; ++j) v[q][j] = __builtin_nontemporal_load((const f32x4*)(xr + 256 * j + 4 * lane)); }
#pragma unroll
        for (int q = 0; q < 4; ++q) { const int row = row0 + q * NGW;
            float s = 0.f;
#pragma unroll
            for (int j = 0; j < 4; ++j) s += (v[q][j].x * v[q][j].x + v[q][j].y * v[q][j].y) + (v[q][j].z * v[q][j].z + v[q][j].w * v[q][j].w);
#pragma unroll
            for (int o = 1; o < 64; o <<= 1) s += __shfl_xor(s, o);
            if (has[q]) {
#pragma unroll
                for (int j = 0; j < 4; ++j) *(u32x2*)(xb + (size_t)row * DM + 256 * j + 4 * lane) = (u32x2){pk2(v[q][j].x, v[q][j].y), pk2(v[q][j].z, v[q][j].w)};
                if (lane < 16) ss0[(size_t)row * 16 + lane] = lane == 0 ? s : 0.f;
            }
        }
    }
    if (bid == 0) { unsigned* bw = (unsigned*)(ws + OFF_BAR); for (int i = tid; i < XCD_BAR_WORDS; i += 512) bw[i] = 0u; }
    { float* ss3 = (float*)(ws + OFF_SS + 3 * SS_BYTES); for (int i = bid * 512 + tid; i < M_TOK * 4; i += G * 512) ((f32x4*)ss3)[i] = (f32x4){-1.f, -1.f, -1.f, -1.f}; }
    {
        bf16_t* wrf = (bf16_t*)(ws + OFF_WRF);
        for (int idx = bid * 512 + tid; idx < 32768; idx += G * 512) { const int k = idx >> 5, col = idx & 31;
            const float w = p.in[7][(size_t)k * NINL + 2304 + col] * p.in[6][k];
            wrf[(((k >> 4) * 64) + ((k >> 3) & 1) * 32 + col) * 8 + (k & 7)] = (bf16_t)(pk2(w, 0.f) & 0xffffu); }
    }
    {
        float* sm = (float*)(ws + OFF_SMALL);
        for (int i = bid * 512 + tid; i < SM_TOTAL; i += G * 512) {
            float v = 0.f;
            if (i < SM_WDF) { if (i < 8) v = p.in[8][i]; }
            else if (i < SM_BDF) v = p.in[9][i - SM_WDF];
            else if (i < SM_WDB) v = p.in[10][i - SM_BDF];
            else if (i < SM_BDB) v = p.in[11][i - SM_WDB];
            else if (i < SM_GN) v = p.in[12][i - SM_BDB];
            else if (i < SM_NF) v = p.in[13][i - SM_GN];
            else v = p.in[19][i - SM_NF];
            sm[i] = v;
        }
    }
    float* cosT = (float*)(ws + OFF_ROPE); float* sinT = cosT + 8192 * 32;
    for (int idx = bid * 512 + tid; idx < 8192 * 32; idx += G * 512) {
        const int t = idx >> 5, i = idx & 31;
        const float inv = (float)exp2(-(double)i * (13.287712379549449 / 32.0));
        const float ang = (float)t * inv;
        const double rev = (double)ang * 0.15915494309189535; const double fr = rev - rint(rev);
        const float a = (float)(fr * 6.283185307179586);
        cosT[idx] = cosf(a); sinT[idx] = sinf(a);
    }
}

DI void attn_unit(unsigned char* ws, LAS unsigned char* lds, int unit, int tid) {
    asm volatile("" : "+v"(tid));
    const int wave = tid >> 6, lane = tid & 63, r = lane & 31, h = lane >> 5, q4 = (lane & 15) >> 2, p4 = lane & 3, blk = (lane >> 4) & 1;
    const int qblk = unit >> 1, hk = unit & 1, row0 = qblk * 128;
    const int T = row0 < MP ? 2048 : 8192, pos0 = row0 & (T - 1);
    const int jmin = pos0 == 0 ? 128 : 0, jmax = (pos0 + 128 == T) ? 256 : 384;
    const bf16_t* qr = (const bf16_t*)(ws + OFF_Q); const bf16_t* kr = (const bf16_t*)(ws + OFF_K); const bf16_t* vr = (const bf16_t*)(ws + OFF_V);
    bf16_t* mix = (bf16_t*)(ws + OFF_MIX);
    LAS unsigned char* Kl = lds; LAS unsigned char* Vl = lds + 384 * 144;
    const int g = wave >> 1, half = wave & 1, head = hk * 4 + g;
    const float sinkl = ((const float*)(ws + OFF_SMALL))[SM_SINK + head] * LOG2E;
    bf16x8 qf[2][4];
#pragma unroll
    for (int qb = 0; qb < 2; ++qb)
#pragma unroll
        for (int s = 0; s < 4; ++s) qf[qb][s] = *(const bf16x8*)(qr + (size_t)(row0 + 64 * half + 32 * qb + r) * 512 + head * 64 + 16 * s + 8 * h);
    {
        u32x4 st[12];
#pragma unroll
        for (int i = 0; i < 12; ++i) { const int e = tid + 512 * i, which = i >= 6, f = which ? e - 3072 : e, j = f >> 3, c = f & 7;
            st[i] = (u32x4){0u, 0u, 0u, 0u};
            if (j >= jmin && j < jmax) st[i] = *(const u32x4*)((which ? vr : kr) + (size_t)(row0 - 128 + j) * 128 + hk * 64 + c * 8); }
#pragma unroll
        for (int i = 0; i < 12; ++i) { const int e = tid + 512 * i, which = i >= 6, f = which ? e - 3072 : e, j = f >> 3, c = f & 7;
            *(LAS u32x4*)((which ? Vl : Kl) + j * 144 + c * 16) = st[i]; }
    }
    __syncthreads();
    f32x16 o[2][2];
#pragma unroll
    for (int a = 0; a < 2; ++a)
#pragma unroll
        for (int b = 0; b < 2; ++b)
#pragma unroll
            for (int i = 0; i < 16; ++i) o[a][b][i] = 0.f;
    float mrun[2] = {sinkl, sinkl}, lrun[2] = {h == 0 ? 1.f : 0.f, h == 0 ? 1.f : 0.f};
    const bool seqedge = (jmin != 0) || (jmax != 384);
    bf16x8 kf[4], vf[2][2];
#define ATT_LOAD(KF, VF, KB) do { _Pragma("unroll") for (int s = 0; s < 4; ++s) KF[s] = *(const LAS bf16x8*)(Kl + (32 * (KB) + r) * 144 + (16 * s + 8 * h) * 2); \
        _Pragma("unroll") for (int db = 0; db < 2; ++db) _Pragma("unroll") for (int s2 = 0; s2 < 2; ++s2) { LAS unsigned char* a_ = Vl + (32 * (KB) + 16 * s2 + 4 * h + q4) * 144 + (32 * db + 16 * blk + 4 * p4) * 2; \
            VF[db][s2] = cat8(trr(a_), trr(a_ + 8 * 144)); } } while (0)
    ATT_LOAD(kf, vf, 2 * half);
#pragma unroll 2
    for (int kb = 2 * half; kb < 2 * half + 10; ++kb) {
        bf16x8 kfn[4], vfn[2][2];
        { const int kn = kb + 1 < 12 ? kb + 1 : 11; ATT_LOAD(kfn, vfn, kn); }
#pragma unroll
        for (int qb = 0; qb < 2; ++qb) {
            const int qd = kb - (2 * half + qb);
            if (qd < 0 || qd > 8) continue;
            f32x16 x;
#pragma unroll
            for (int i = 0; i < 16; ++i) x[i] = 0.f;
#pragma unroll
            for (int s = 0; s < 4; ++s) x = MFMA32(kf[s], qf[qb][s], x);
            float bm = -1e30f;
            if (qd == 0 || qd == 8 || seqedge) {
                const int qi = 64 * half + 32 * qb + r, base = 32 * kb + 4 * h;
                const int lo = max(qi, jmin) - base, hi = min(qi + 256, jmax - 1) - base;
#pragma unroll
                for (int i = 0; i < 16; ++i) { const int c = (i & 3) + 8 * (i >> 2);
                    x[i] = (c >= lo && c <= hi) ? x[i] : -1e30f; bm = fmaxf(bm, x[i]); }
            } else {
#pragma unroll
                for (int i = 0; i < 16; ++i) bm = fmaxf(bm, x[i]);
            }
            bm = xh_max(bm);
            const float mo = mrun[qb], mn = fmaxf(mo, bm);
            mrun[qb] = mn;
            float ps = 0.f;
#pragma unroll
            for (int i = 0; i < 16; ++i) { x[i] = __builtin_amdgcn_exp2f(x[i] - mn); ps += x[i]; }
            if (__builtin_amdgcn_ballot_w64(mn > mo) != 0ull) {
                const float alpha = __builtin_amdgcn_exp2f(mo - mn);
                lrun[qb] *= alpha;
#pragma unroll
                for (int db = 0; db < 2; ++db)
#pragma unroll
                    for (int i = 0; i < 16; ++i) o[qb][db][i] *= alpha;
            }
            lrun[qb] += ps;
            const bf16x8 pk0 = pack8(x[0], x[1], x[2], x[3], x[4], x[5], x[6], x[7]), pk1 = pack8(x[8], x[9], x[10], x[11], x[12], x[13], x[14], x[15]);
#pragma unroll
            for (int db = 0; db < 2; ++db) { o[qb][db] = MFMA32(vf[db][0], pk0, o[qb][db]); o[qb][db] = MFMA32(vf[db][1], pk1, o[qb][db]); }
        }
#pragma unroll
        for (int s = 0; s < 4; ++s) kf[s] = kfn[s];
#pragma unroll
        for (int db = 0; db < 2; ++db) { vf[db][0] = vfn[db][0]; vf[db][1] = vfn[db][1]; }
    }
#undef ATT_LOAD
#pragma unroll
    for (int qb = 0; qb < 2; ++qb) {
        const float lt = xh_sum(lrun[qb]), inv = __builtin_amdgcn_rcpf(lt);
        bf16_t* dst = mix + (size_t)(row0 + 64 * half + 32 * qb + r) * DM + head * 64 + 8 * h;
#pragma unroll
        for (int db = 0; db < 2; ++db)
#pragma unroll
            for (int g2 = 0; g2 < 2; ++g2) {
                const u32x2 wa = {pk2(o[qb][db][8 * g2] * inv, o[qb][db][8 * g2 + 1] * inv), pk2(o[qb][db][8 * g2 + 2] * inv, o[qb][db][8 * g2 + 3] * inv)};
                const u32x2 wb = {pk2(o[qb][db][8 * g2 + 4] * inv, o[qb][db][8 * g2 + 5] * inv), pk2(o[qb][db][8 * g2 + 6] * inv, o[qb][db][8 * g2 + 7] * inv)};
                *(u32x4*)(dst + 32 * db + 16 * g2) = widen_pair(wa, wb); }
    }
    __syncthreads();
}
constexpr int GL_RF = 0, GL_TOT = 8192, GL_VIM = 12288, GL_EIM = 47104, VIM_ST = 544, EIM_ST = 144;
DI float logsig(float z) { return fminf(z, 0.f) - __logf(1.0f + __expf(-fabsf(z))); }
typedef unsigned short u16x2 __attribute__((ext_vector_type(2)));
struct GlaPre { u16x2 kq[16]; f32x4 rf; u32x4 vst[4]; };
template <int PASS> DI void gla_load(GlaPre& P, unsigned char* ws, int unit, int tid) {
    const int wave = tid >> 6, lane = tid & 63, gc = unit >> 1, hp = unit & 1, row0 = gc * 64;
    const bf16_t* gq = (const bf16_t*)(ws + OFF_GQ); const bf16_t* gk = (const bf16_t*)(ws + OFF_GK); const bf16_t* gv = (const bf16_t*)(ws + OFF_GV); const float* rr = (const float*)(ws + OFF_RR);
    const int ch = (hp * 2 + (wave >> 2)) * 64 + lane;
    const bf16_t* kp = gk + (size_t)(row0 + (wave & 3) * 16) * 256 + ch; const bf16_t* qp = gq + (size_t)(row0 + (wave & 3) * 16) * 256 + ch;
#pragma unroll
    for (int t = 0; t < 16; ++t) { u16x2 v; v.x = kp[(size_t)t * 256]; v.y = (PASS == 1) ? qp[(size_t)t * 256] : (unsigned short)0; P.kq[t] = v; }
    P.rf = *(const f32x4*)(rr + (size_t)(row0 + (tid >> 3)) * 32 + (tid & 7) * 4);
#pragma unroll
    for (int i = 0; i < 4; ++i) { const int e = tid + 512 * i, row = e >> 5, c = e & 31; P.vst[i] = *(const u32x4*)(gv + (size_t)(row0 + row) * 512 + hp * 256 + c * 8); }
}
DI void gla_consts(unsigned char* ws, int hp, int tid, float (&wv)[8], float& gbias) {
    const int wave = tid >> 6, lane = tid & 63, r = lane & 31, h = lane >> 5;
    const int hl_ = wave >> 2, dir_ = (wave >> 1) & 1, db_ = wave & 1, ch_ = (hp * 2 + hl_) * 64 + 32 * db_ + r;
    const float* sm = (const float*)(ws + OFF_SMALL); const float* wsrc = sm + (dir_ ? SM_WDB : SM_WDF) + ch_;
#pragma unroll
    for (int j = 0; j < 8; ++j) wv[j] = wsrc[(8 * h + j) * 256];
    gbias = sm[(dir_ ? SM_BDB : SM_BDF) + ch_];
}
template <int PASS> DI void gla_unit(unsigned char* ws, bf16_t* U, LAS unsigned char* lds, int unit, int tid, GlaPre& P, int next_unit, const float (&wv)[8], const float gbias) {
    asm volatile("" : "+v"(tid));
    const int wave = tid >> 6, lane = tid & 63, r = lane & 31, h = lane >> 5, q4 = (lane & 15) >> 2, p4 = lane & 3, blk = (lane >> 4) & 1;
    const int gc = unit >> 1, hp = unit & 1, row0 = gc * 64;
    const bf16_t* sg = (const bf16_t*)(ws + OFF_SG);
    float* decay = (float*)(ws + OFF_DECAY); bf16_t* mix = (bf16_t*)(ws + OFF_MIX);
    unsigned short kraw[16], qraw[16];
#pragma unroll
    for (int t = 0; t < 16; ++t) { kraw[t] = P.kq[t].x; qraw[t] = P.kq[t].y; }
    { const int row = tid >> 3, c = tid & 7; *(LAS f32x4*)(lds + GL_RF + row * 128 + c * 16) = P.rf; }
#pragma unroll
    for (int i = 0; i < 4; ++i) { const int e = tid + 512 * i, row = e >> 5, c = e & 31; *(LAS u32x4*)(lds + GL_VIM + row * VIM_ST + c * 16) = P.vst[i]; }
    __syncthreads();
    {
        const int hl = wave >> 2, dir = (wave >> 1) & 1, db = wave & 1; const float bias = gbias;
        float wl[8];
#pragma unroll
        for (int j = 0; j < 8; ++j) { const float hi = __uint_as_float(pk2(wv[j], 0.f) << 16); wl[j] = wv[j] - hi; }
        const bf16x8 bhi = pack8(wv[0], wv[1], wv[2], wv[3], wv[4], wv[5], wv[6], wv[7]), blo = pack8(wl[0], wl[1], wl[2], wl[3], wl[4], wl[5], wl[6], wl[7]);
        LAS float* Z = (LAS float*)(lds + GL_EIM);
#pragma unroll
        for (int tb = 0; tb < 2; ++tb) {
            const LAS f32x4* rp = (const LAS f32x4*)(lds + GL_RF + (32 * tb + r) * 128 + (dir * 16 + 8 * h) * 4);
            const f32x4 a0 = rp[0], a1 = rp[1];
            const float av[8] = {a0.x, a0.y, a0.z, a0.w, a1.x, a1.y, a1.z, a1.w};
            float al[8];
#pragma unroll
            for (int j = 0; j < 8; ++j) { const float hi = __uint_as_float(pk2(av[j], 0.f) << 16); al[j] = av[j] - hi; }
            const bf16x8 ahi = pack8(av[0], av[1], av[2], av[3], av[4], av[5], av[6], av[7]), alo = pack8(al[0], al[1], al[2], al[3], al[4], al[5], al[6], al[7]);
            f32x16 z;
#pragma unroll
            for (int i = 0; i < 16; ++i) z[i] = bias;
            z = MFMA32(ahi, bhi, z); z = MFMA32(alo, bhi, z); z = MFMA32(ahi, blo, z);
#pragma unroll
            for (int i = 0; i < 16; ++i) Z[((hl * 2 + dir) * 64 + 32 * tb + crow(i, h)) * 64 + 32 * db + r] = logsig(z[i]) * (0.0625f * LOG2E);
        }
    }
    __syncthreads();
    if (PASS != 3) {
        const int hl = wave >> 2, seg = wave & 3, head = hp * 2 + hl, d = lane, ch = head * 64 + d;
        float laf[16], lab[16], sf = 0.f, sb = 0.f;
        {   const LAS float* Z = (const LAS float*)(lds + GL_EIM);
#pragma unroll
            for (int t = 0; t < 16; ++t) { laf[t] = Z[((hl * 2 + 0) * 64 + seg * 16 + t) * 64 + d]; lab[t] = Z[((hl * 2 + 1) * 64 + seg * 16 + t) * 64 + d]; sf += laf[t]; sb += lab[t]; }
        }
        LAS float* tot = (LAS float*)(lds + GL_TOT);
        tot[((hl * 2 + 0) * 4 + seg) * 64 + d] = sf; tot[((hl * 2 + 1) * 4 + seg) * 64 + d] = sb;
        __syncthreads();
        float pref_f = 0.f, suff_f = 0.f, pref_b = 0.f, suff_b = 0.f;
#pragma unroll
        for (int s = 0; s < 4; ++s) { const float a = tot[((hl * 2 + 0) * 4 + s) * 64 + d], b = tot[((hl * 2 + 1) * 4 + s) * 64 + d];
            if (s < seg) { pref_f += a; pref_b += b; } else if (s > seg) { suff_f += a; suff_b += b; } }
        float kv[16];
#pragma unroll
        for (int t = 0; t < 16; ++t) kv[t] = bf2f(kraw[t]);
        LAS unsigned char* eim = lds + GL_EIM + (hl * 4 * 64 + d) * EIM_ST + seg * 32;
        if (PASS == 0) {
            float o[16]; float run = suff_f;
#pragma unroll
            for (int t = 15; t >= 0; --t) { o[t] = kv[t] * __builtin_amdgcn_exp2f(run); run += laf[t]; }
            *(LAS u32x4*)(eim) = (u32x4){pk2(o[0], o[1]), pk2(o[2], o[3]), pk2(o[4], o[5]), pk2(o[6], o[7])};
            *(LAS u32x4*)(eim + 16) = (u32x4){pk2(o[8], o[9]), pk2(o[10], o[11]), pk2(o[12], o[13]), pk2(o[14], o[15])};
            run = pref_b;
#pragma unroll
            for (int t = 0; t < 16; ++t) { o[t] = kv[t] * __builtin_amdgcn_exp2f(run); run += lab[t]; }
            *(LAS u32x4*)(eim + 64 * EIM_ST) = (u32x4){pk2(o[0], o[1]), pk2(o[2], o[3]), pk2(o[4], o[5]), pk2(o[6], o[7])};
            *(LAS u32x4*)(eim + 64 * EIM_ST + 16) = (u32x4){pk2(o[8], o[9]), pk2(o[10], o[11]), pk2(o[12], o[13]), pk2(o[14], o[15])};
            if (seg == 0) { decay[(size_t)((gc * 4 + head) * 2 + 0) * 64 + d] = __builtin_amdgcn_exp2f(sf + suff_f); decay[(size_t)((gc * 4 + head) * 2 + 1) * 64 + d] = __builtin_amdgcn_exp2f(sb + suff_b); }
        } else {
            float qv[16];
#pragma unroll
            for (int t = 0; t < 16; ++t) qv[t] = bf2f(qraw[t]);
            float oq[16], ok[16]; float run = pref_f;
#pragma unroll
            for (int t = 0; t < 16; ++t) { run += laf[t]; oq[t] = qv[t] * __builtin_amdgcn_exp2f(run); ok[t] = kv[t] * __builtin_amdgcn_exp2f(-run); }
            *(LAS u32x4*)(eim) = (u32x4){pk2(oq[0], oq[1]), pk2(oq[2], oq[3]), pk2(oq[4], oq[5]), pk2(oq[6], oq[7])};
            *(LAS u32x4*)(eim + 16) = (u32x4){pk2(oq[8], oq[9]), pk2(oq[10], oq[11]), pk2(oq[12], oq[13]), pk2(oq[14], oq[15])};
            *(LAS u32x4*)(eim + 64 * EIM_ST) = (u32x4){pk2(ok[0], ok[1]), pk2(ok[2], ok[3]), pk2(ok[4], ok[5]), pk2(ok[6], ok[7])};
            *(LAS u32x4*)(eim + 64 * EIM_ST + 16) = (u32x4){pk2(ok[8], ok[9]), pk2(ok[10], ok[11]), pk2(ok[12], ok[13]), pk2(ok[14], ok[15])};
            run = suff_b;
#pragma unroll
            for (int t = 15; t >= 0; --t) { run += lab[t]; oq[t] = qv[t] * __builtin_amdgcn_exp2f(run); ok[t] = kv[t] * __builtin_amdgcn_exp2f(-run); }
            *(LAS u32x4*)(eim + 128 * EIM_ST) = (u32x4){pk2(oq[0], oq[1]), pk2(oq[2], oq[3]), pk2(oq[4], oq[5]), pk2(oq[6], oq[7])};
            *(LAS u32x4*)(eim + 128 * EIM_ST + 16) = (u32x4){pk2(oq[8], oq[9]), pk2(oq[10], oq[11]), pk2(oq[12], oq[13]), pk2(oq[14], oq[15])};
            *(LAS u32x4*)(eim + 192 * EIM_ST) = (u32x4){pk2(ok[0], ok[1]), pk2(ok[2], ok[3]), pk2(ok[4], ok[5]), pk2(ok[6], ok[7])};
            *(LAS u32x4*)(eim + 192 * EIM_ST + 16) = (u32x4){pk2(ok[8], ok[9]), pk2(ok[10], ok[11]), pk2(ok[12], ok[13]), pk2(ok[14], ok[15])};
        }
    }
    __syncthreads();
    if (next_unit >= 0) gla_load<PASS>(P, ws, next_unit, tid);
    if (PASS == 0) {
        const int hl = wave >> 2, dblk = (wave >> 1) & 1, dvh = wave & 1, head = hp * 2 + hl;
#pragma unroll
        for (int dir = 0; dir < 2; ++dir) {
            f32x16 acc[2];
#pragma unroll
            for (int a = 0; a < 2; ++a)
#pragma unroll
                for (int i = 0; i < 16; ++i) acc[a][i] = 0.f;
#pragma unroll
            for (int s = 0; s < 4; ++s) {
                const bf16x8 af = *(const LAS bf16x8*)(lds + GL_EIM + ((hl * 4 + dir) * 64 + 32 * dblk + r) * EIM_ST + (16 * s + 8 * h) * 2);
#pragma unroll
                for (int dv2 = 0; dv2 < 2; ++dv2) { const int dvblk = 2 * dvh + dv2;
                    LAS unsigned char* a = lds + GL_VIM + (16 * s + 8 * h + q4) * VIM_ST + (hl * 128 + 32 * dvblk + 16 * blk + 4 * p4) * 2;
                    acc[dv2] = MFMA32(af, cat8(trr(a), trr(a + 4 * VIM_ST)), acc[dv2]); }
            }
            bf16_t* up = U + (size_t)((gc * 4 + head) * 2 + dir) * 8192;
#pragma unroll
            for (int dv2 = 0; dv2 < 2; ++dv2)
#pragma unroll
                for (int s2 = 0; s2 < 2; ++s2) { const int dvblk = 2 * dvh + dv2;
                    *(bf16x8*)(up + (((dblk * 4 + dvblk) * 2 + s2) * 64 + lane) * 8) =
                        pack8(acc[dv2][8 * s2], acc[dv2][8 * s2 + 1], acc[dv2][8 * s2 + 2], acc[dv2][8 * s2 + 3], acc[dv2][8 * s2 + 4], acc[dv2][8 * s2 + 5], acc[dv2][8 * s2 + 6], acc[dv2][8 * s2 + 7]); }
        }
    } else {
        const int hl = wave >> 2, ib = (wave >> 1) & 1, dvh = wave & 1, head = hp * 2 + hl;
        const int row = row0 + 32 * ib + r;
        u32x2 sgv[2][4];
#pragma unroll
        for (int dv2 = 0; dv2 < 2; ++dv2)
#pragma unroll
            for (int g4 = 0; g4 < 4; ++g4) sgv[dv2][g4] = *(const u32x2*)(sg + (size_t)row * 512 + head * 128 + 32 * (2 * dvh + dv2) + 8 * g4 + 4 * h);
        f32x16 y[2];
#pragma unroll
        for (int a2 = 0; a2 < 2; ++a2)
#pragma unroll
            for (int i = 0; i < 16; ++i) y[a2][i] = 0.f;
#pragma unroll
        for (int dir = 0; dir < 2; ++dir) {
            LAS unsigned char* QE = lds + GL_EIM + ((hl * 4 + 2 * dir) * 64) * EIM_ST; LAS unsigned char* KE = QE + 64 * EIM_ST;
            bf16x8 sfr[4][2]; bf16x8 qfr[4];
            { const bf16_t* sp = U + (size_t)((gc * 4 + head) * 2 + dir) * 8192;
#pragma unroll
                for (int sx = 0; sx < 4; ++sx)
#pragma unroll
                    for (int dv2 = 0; dv2 < 2; ++dv2) sfr[sx][dv2] = *(const bf16x8*)(sp + ((((sx >> 1) * 4 + 2 * dvh + dv2) * 2 + (sx & 1)) * 64 + lane) * 8); }
#pragma unroll
            for (int sx = 0; sx < 4; ++sx) { LAS unsigned char* a2 = QE + (16 * sx + 4 * h + q4) * EIM_ST + (32 * ib + 16 * blk + 4 * p4) * 2; qfr[sx] = cat8(trr(a2), trr(a2 + 8 * EIM_ST)); }
#pragma unroll
            for (int jb = 0; jb < 2; ++jb) {
                const bool need = dir == 0 ? (jb <= ib) : (jb >= ib);
                if (need) {
                    f32x16 x;
#pragma unroll
                    for (int i = 0; i < 16; ++i) x[i] = 0.f;
#pragma unroll
                    for (int sx = 0; sx < 4; ++sx) { LAS unsigned char* a2 = KE + (16 * sx + 4 * h + q4) * EIM_ST + (32 * jb + 16 * blk + 4 * p4) * 2; x = MFMA32(cat8(trr(a2), trr(a2 + 8 * EIM_ST)), qfr[sx], x); }
                    if (jb == ib) {
#pragma unroll
                        for (int i = 0; i < 16; ++i) { const int jj = crow(i, h); const bool keep = dir == 0 ? (jj <= r) : (jj > r); x[i] = keep ? x[i] : 0.f; }
                    }
                    const bf16x8 pk0 = pack8(x[0], x[1], x[2], x[3], x[4], x[5], x[6], x[7]), pk1 = pack8(x[8], x[9], x[10], x[11], x[12], x[13], x[14], x[15]);
#pragma unroll
                    for (int dv2 = 0; dv2 < 2; ++dv2) {
                        LAS unsigned char* a2 = lds + GL_VIM + (32 * jb + 4 * h + q4) * VIM_ST + (hl * 128 + 32 * (2 * dvh + dv2) + 16 * blk + 4 * p4) * 2;
                        y[dv2] = MFMA32(cat8(trr(a2), trr(a2 + 8 * VIM_ST)), pk0, y[dv2]);
                        y[dv2] = MFMA32(cat8(trr(a2 + 16 * VIM_ST), trr(a2 + 24 * VIM_ST)), pk1, y[dv2]); }
                }
            }
#pragma unroll
            for (int sx = 0; sx < 4; ++sx)
#pragma unroll
                for (int dv2 = 0; dv2 < 2; ++dv2) y[dv2] = MFMA32(sfr[sx][dv2], qfr[sx], y[dv2]);
        }
        float ssum = 0.f;
#pragma unroll
        for (int a2 = 0; a2 < 2; ++a2)
#pragma unroll
            for (int i = 0; i < 16; ++i) ssum += y[a2][i] * y[a2][i];
        ssum = xh_sum(ssum);
        LAS float* part = (LAS float*)(lds + GL_TOT);
        if (h == 0) part[wave * 32 + r] = ssum;
        __syncthreads();
        ssum += part[(wave ^ 1) * 32 + r];
        const float rstd = rsqrtf(ssum * (1.0f / 128.0f) + EPS);
#pragma unroll
        for (int dv2 = 0; dv2 < 2; ++dv2)
#pragma unroll
            for (int g2 = 0; g2 < 2; ++g2) {
                u32x2 w[2];
#pragma unroll
                for (int q = 0; q < 2; ++q) { const int g4 = 2 * g2 + q, dv = 32 * (2 * dvh + dv2) + 8 * g4 + 4 * h;
                    const f32x4 gn = *(const f32x4*)((const float*)(ws + OFF_SMALL) + SM_GN + dv);
                    const u32x2 sv = sgv[dv2][g4];
                    const float o0 = y[dv2][4 * g4] * rstd * gn.x * bflo(sv.x), o1 = y[dv2][4 * g4 + 1] * rstd * gn.y * bfhi(sv.x);
                    const float o2 = y[dv2][4 * g4 + 2] * rstd * gn.z * bflo(sv.y), o3 = y[dv2][4 * g4 + 3] * rstd * gn.w * bfhi(sv.y);
                    w[q] = (u32x2){pk2(o0, o1), pk2(o2, o3)}; }
                *(u32x4*)(mix + (size_t)row * DM + 512 + head * 128 + 32 * (2 * dvh + dv2) + 16 * g2 + 8 * h) = widen_pair(w[0], w[1]); }
    }
    __syncthreads();
}
DI void gla_scan(unsigned char* ws, bf16_t* U, int gtid) {
    if (gtid >= 96 * 1024) return;
    const int chain = gtid >> 10, e = gtid & 1023, lane = e & 63, fi = e >> 6, s2 = fi & 1, dblk = fi >> 3, h = lane >> 5;
    const int sq = chain >> 3, head = (chain >> 1) & 3, dir = chain & 1;
    const int g0 = sq < 8 ? 32 * sq : 256 + 128 * (sq - 8), n = sq < 8 ? 32 : 128;
    const int dbase = 32 * dblk + 16 * s2 + 4 * h;
    const float* decay = (const float*)(ws + OFF_DECAY);
    float S[8];
#pragma unroll
    for (int j = 0; j < 8; ++j) S[j] = 0.f;
    for (int c0 = 0; c0 < n; c0 += 16) {
        u32x4 uv[16]; f32x4 dl[16], dh[16];
#pragma unroll
        for (int i = 0; i < 16; ++i) { const int gc = dir ? g0 + n - 1 - (c0 + i) : g0 + c0 + i; const size_t it = (size_t)((gc * 4 + head) * 2 + dir);
            uv[i] = *(const u32x4*)(U + it * 8192 + e * 8); dl[i] = *(const f32x4*)(decay + it * 64 + dbase); dh[i] = *(const f32x4*)(decay + it * 64 + dbase + 8); }
#pragma unroll
        for (int i = 0; i < 16; ++i) { const int gc = dir ? g0 + n - 1 - (c0 + i) : g0 + c0 + i; const size_t it = (size_t)((gc * 4 + head) * 2 + dir);
            *(u32x4*)(U + it * 8192 + e * 8) = (u32x4){pk2(S[0], S[1]), pk2(S[2], S[3]), pk2(S[4], S[5]), pk2(S[6], S[7])};
            S[0] = dl[i].x * S[0] + bflo(uv[i].x); S[1] = dl[i].y * S[1] + bfhi(uv[i].x); S[2] = dl[i].z * S[2] + bflo(uv[i].y); S[3] = dl[i].w * S[3] + bfhi(uv[i].y);
            S[4] = dh[i].x * S[4] + bflo(uv[i].z); S[5] = dh[i].y * S[5] + bfhi(uv[i].z); S[6] = dh[i].z * S[6] + bflo(uv[i].w); S[7] = dh[i].w * S[7] + bfhi(uv[i].w); }
    }
}
DI void rgate_panel(unsigned char* ws, LAS unsigned char* lds, int pm, int tid) {
    const int wid = tid >> 6, lane = tid & 63, r = lane & 31, h = lane >> 5, rowb = pm * 256 + wid * 32;
    LAS float* sc = (LAS float*)lds + wid * 32;
    if (h == 0) sc[r] = rsqrtf(row_ss((const float*)(ws + OFF_SS + SS_BYTES), rowb + r) * (1.0f / DM) + EPS);
    const bf16_t* xa = (const bf16_t*)(ws + OFF_XB) + (size_t)(rowb + r) * DM + 8 * h;
    const bf16_t* wf = (const bf16_t*)(ws + OFF_WRF) + lane * 8;
    f32x16 z;
#pragma unroll
    for (int i = 0; i < 16; ++i) z[i] = 0.f;
#pragma unroll 16
    for (int sx = 0; sx < 64; ++sx) z = MFMA32(*(const bf16x8*)(xa + 16 * sx), *(const bf16x8*)(wf + sx * 512), z);
    lds_wait();
    float* rr = (float*)(ws + OFF_RR) + (size_t)rowb * 32 + r;
#pragma unroll
    for (int i = 0; i < 16; ++i) { const int row = crow(i, h); rr[row * 32] = z[i] * sc[row]; }
    lds_wait();
}
__global__ void __launch_bounds__(512, 2) hymba_fwd(Params p) {
    extern __shared__ __attribute__((aligned(16))) unsigned char shm[];
    LAS unsigned char* lds = (LAS unsigned char*)shm;
    cg::grid_group grid = cg::this_grid();
#define FRESH_WS() unsigned char* ws = opq_p(p.ws); int tid = threadIdx.x; asm volatile("" : "+v"(tid)); const int bid = opq_i(blockIdx.x), G = opq_i(gridDim.x)
#define GBAR(k) do { unsigned* _c = (unsigned*)(opq_p(p.ws) + OFF_BAR); xcd_barrier(_c, (volatile LAS unsigned*)(lds + XB_LDS_OFF)); } while (0)
    if (threadIdx.x < 4) ((volatile LAS unsigned*)(lds + XB_LDS_OFF))[threadIdx.x] = 0u;
    { FRESH_WS(); p0_prologue(p, lds, tid, G, bid); }
    grid.sync();
    if (threadIdx.x == 0) (void)xb_add(&((unsigned*)(opq_p(p.ws) + OFF_BAR))[XB_XCNT(xb_xcc_id())], 1u);
    {
        FRESH_WS();
        pg8::Gemm g{(const bf16_t*)(ws + OFF_XB), (const bf16_t*)(ws + OFF_WGU1), M_TOK, NGU, DM};
        EpiSwiglu E{(bf16_t*)(ws + OFF_BIG), (LAS float*)(lds + RSTD_OFF)};
        pg8::StaticOrder S; S.init(M_TOK, NGU, G, bid);
        rstd_prepass((LAS float*)(lds + RSTD_OFF), (const float*)(ws + OFF_SS), S, tid);
        pg8::gemm_phase(lds, g, S, E, tid);
        if (bid >= (G >> 1)) { const int nb = G - (G >> 1); p0_weights(p, lds, tid, (bid - (G >> 1)) * 8 + (tid >> 6), nb * 8, 2816, 10112); }
    }
    GBAR(1);
    {
        FRESH_WS();
        pg8::Gemm g{(const bf16_t*)(ws + OFF_BIG), (const bf16_t*)(ws + OFF_WD1), M_TOK, DM, FF};
        EpiResid E{(bf16_t*)(ws + OFF_XB), (float*)(ws + OFF_SS + 1 * SS_BYTES), 0.5f};
        pg8::StaticOrder S; S.init(M_TOK, DM, G, bid);
        pg8::gemm_phase(lds, g, S, E, tid);
    }
    GBAR(2);
    {
        FRESH_WS();
        pg8::Gemm g{(const bf16_t*)(ws + OFF_XB), (const bf16_t*)(ws + OFF_WIN), M_TOK, NIN, DM};
        EpiInProj E{ws, (LAS float*)(lds + RSTD_OFF)};
        pg8::StaticOrder S; S.init(M_TOK, NIN, G, bid);
        rstd_prepass((LAS float*)(lds + RSTD_OFF), (const float*)(ws + OFF_SS + 1 * SS_BYTES), S, tid);
        pg8::gemm_phase(lds, g, S, E, tid);
        {
            const int nfull = ((M_TOK / 256) * (NIN / 256)) % G, nb = nfull ? G - nfull : G, b0 = nfull ? nfull : 0;
            if (bid >= b0) for (int pm = bid - b0; pm < M_TOK / 256; pm += nb) rgate_panel(ws, lds, pm, tid);
        }
    }
    GBAR(3);
    {
        FRESH_WS();
        {
            const int vb = (bid & 7) * (G >> 3) + (bid >> 3);
            for (int uu = vb; uu < 768; uu += G) { const int hk = uu >= 384 ? 1 : 0, qb_ = uu - 384 * hk; attn_unit(ws, lds, qb_ * 2 + hk, tid); }
        }
        {   GlaPre P; float wv[8], gb; gla_consts(ws, bid & 1, tid, wv, gb); bf16_t* U = (bf16_t*)opq_p(p.out);
            if (bid < 1536) gla_load<0>(P, ws, bid, tid);
            for (int u = bid; u < 1536; u += G) gla_unit<0>(ws, U, lds, u, tid, P, (u + G < 1536) ? u + G : -1, wv, gb); }
    }
    GBAR(4);
    { FRESH_WS(); gla_scan(ws, (bf16_t*)opq_p(p.out), bid * 512 + tid); }
    GBAR(5);
    {
        FRESH_WS();
        {   GlaPre P; float wv[8], gb; gla_consts(ws, bid & 1, tid, wv, gb); bf16_t* U = (bf16_t*)opq_p(p.out);
            if (bid < 1536) gla_load<1>(P, ws, bid, tid);
            for (int u = bid; u < 1536; u += G) gla_unit<1>(ws, U, lds, u, tid, P, (u + G < 1536) ? u + G : -1, wv, gb); }
    }
    GBAR(6);
    {
        FRESH_WS();
        pg8::Gemm g{(const bf16_t*)(ws + OFF_MIX), (const bf16_t*)(ws + OFF_WOUT), M_TOK, DM, DM};
        EpiResid E{(bf16_t*)(ws + OFF_XB), (float*)(ws + OFF_SS + 2 * SS_BYTES), 1.0f};
        pg8::StaticOrder S; S.init(M_TOK, DM, G, bid);
        pg8::gemm_phase(lds, g, S, E, tid);
    }
    GBAR(7);
    {
        FRESH_WS();
        pg8::Gemm g{(const bf16_t*)(ws + OFF_XB), (const bf16_t*)(ws + OFF_WGU2), M_TOK, NGU, DM};
        EpiSwiglu E{(bf16_t*)(ws + OFF_BIG), (LAS float*)(lds + RSTD_OFF)};
        pg8::StaticOrder S; S.init(M_TOK, NGU, G, bid);
        rstd_prepass((LAS float*)(lds + RSTD_OFF), (const float*)(ws + OFF_SS + 2 * SS_BYTES), S, tid);
        pg8::gemm_phase(lds, g, S, E, tid);
    }
    GBAR(8);
    {
        FRESH_WS();
        pg8::Gemm g{(const bf16_t*)(ws + OFF_BIG), (const bf16_t*)(ws + OFF_WD2), M_TOK, DM, FF};
        EpiFinal E{p.out, (const bf16_t*)(ws + OFF_XB), (float*)(ws + OFF_SS + 3 * SS_BYTES), (const float*)(ws + OFF_SMALL) + SM_NF};
        pg8::StaticOrder S; S.init(M_TOK, DM, G, bid);
        pg8::gemm_phase(lds, g, S, E, tid);
    }
}

extern "C" void kernel_launch(void* const* d_in, const int* in_sizes, int n_in, void* d_out, int out_size, void* d_ws, size_t ws_size, hipStream_t stream) {
    static int grid_blocks = 0;
    if (!grid_blocks) {
        int dev = 0, cus = 0, per_cu = 0;
        hipGetDevice(&dev);
        hipDeviceGetAttribute(&cus, hipDeviceAttributeMultiprocessorCount, dev);
        hipFuncSetAttribute((const void*)hymba_fwd, hipFuncAttributeMaxDynamicSharedMemorySize, LDS_BYTES);
        hipOccupancyMaxActiveBlocksPerMultiprocessor(&per_cu, (const void*)hymba_fwd, 512, LDS_BYTES);
        if (per_cu < 1) { fprintf(stderr, "occupancy query returned %d\n", per_cu); per_cu = 1; }
        grid_blocks = cus * per_cu;
        if (grid_blocks > 256) grid_blocks = 256;
    }
    Params p{};
    for (int i = 0; i < 20; ++i) p.in[i] = (const float*)d_in[i];
    p.out = (float*)d_out; p.ws = (unsigned char*)d_ws;
    void* args[] = {&p};
    hipError_t e = hipLaunchCooperativeKernel((const void*)hymba_fwd, dim3(grid_blocks), dim3(512), args, LDS_BYTES, stream);
    if (e != hipSuccess) fprintf(stderr, "cooperative launch failed: %s (grid %d)\n", hipGetErrorString(e), grid_blocks);
}
```
